# Optimizing an MI355X kernel written in HIP

```python
import math
import jax, jax.numpy as jnp
from jax import lax
import numpy as np

D_MODEL = 1024
BATCH = 4
SEQ = 4096
DEPTH = 1

D_MIX = D_MODEL
D_ATTN = D_MIX // 2
D_SSM = D_MIX - D_ATTN
HEAD_DIM = 64
N_Q_HEADS = D_ATTN // HEAD_DIM
N_KV_HEADS = 2
GQA_GROUP = N_Q_HEADS // N_KV_HEADS
WINDOW = 128
BLOCK = 128
HALO_BLOCKS = -(-WINDOW // BLOCK)
ROPE_THETA = 10000.0
SSM_CH = 16
N_SSM_GROUPS = D_SSM // SSM_CH
SSM_STATE = 64
N_DIR = 2
DT_MIN = 1e-3
DT_MAX = 1e-1
NORM_EPS = 1e-5
NEG_INF = -1e30
DEEPNORM_ALPHA = (2.0 * DEPTH) ** 0.25
DEEPNORM_BETA = (8.0 * DEPTH) ** -0.25
Q_COLS = N_Q_HEADS * HEAD_DIM
KV_COLS = N_KV_HEADS * HEAD_DIM
D_IN_PROJ = Q_COLS + 2 * KV_COLS + D_ATTN + D_SSM + D_SSM
SPLITS = [Q_COLS, Q_COLS + KV_COLS, Q_COLS + 2 * KV_COLS,
          Q_COLS + 2 * KV_COLS + D_ATTN, Q_COLS + 2 * KV_COLS + D_ATTN + D_SSM]

kernel_name = "hymba_deepnorm_swa_s5_encoder"


def layer_norm(x, g, b):
    xf = x.astype(jnp.float32)
    mu = jnp.mean(xf, axis=-1, keepdims=True)
    var = jnp.mean(jnp.square(xf - mu), axis=-1, keepdims=True)
    y = (xf - mu) * lax.rsqrt(var + NORM_EPS)
    return (y * g.astype(jnp.float32) + b.astype(jnp.float32)).astype(x.dtype)


def rms_norm(x, g):
    xf = x.astype(jnp.float32)
    y = xf * lax.rsqrt(jnp.mean(jnp.square(xf), axis=-1, keepdims=True) + NORM_EPS)
    return (y * g.astype(jnp.float32)).astype(x.dtype)


def rope(x, pos):
    half = HEAD_DIM // 2
    inv_freq = ROPE_THETA ** (-jnp.arange(half, dtype=jnp.float32) / half)
    ang = pos.astype(jnp.float32)[:, None] * inv_freq[None, :]
    cos = jnp.cos(ang)[None, :, None, :].astype(x.dtype)
    sin = jnp.sin(ang)[None, :, None, :].astype(x.dtype)
    x1, x2 = x[..., :half], x[..., half:]
    return jnp.concatenate([x1 * cos - x2 * sin, x2 * cos + x1 * sin], axis=-1)


def windowed_gqa_with_sink(q, k, v, sink):
    b, s = q.shape[0], q.shape[1]
    nb = s // BLOCK
    pad = HALO_BLOCKS * BLOCK
    span = 2 * HALO_BLOCKS + 1
    n_keys = span * BLOCK
    kp = jnp.pad(k, ((0, 0), (pad, pad), (0, 0), (0, 0))).reshape(b, nb + 2 * HALO_BLOCKS, BLOCK, N_KV_HEADS, HEAD_DIM)
    vp = jnp.pad(v, ((0, 0), (pad, pad), (0, 0), (0, 0))).reshape(b, nb + 2 * HALO_BLOCKS, BLOCK, N_KV_HEADS, HEAD_DIM)
    kb = jnp.concatenate([kp[:, j:j + nb] for j in range(span)], axis=2)
    vb = jnp.concatenate([vp[:, j:j + nb] for j in range(span)], axis=2)
    qb = q.reshape(b, nb, BLOCK, N_KV_HEADS, GQA_GROUP, HEAD_DIM)
    scale = HEAD_DIM ** -0.5
    scores = jnp.einsum('bnqgrd,bnkgd->bngrqk', qb, kb).astype(jnp.float32) * scale
    blk = jnp.arange(nb, dtype=jnp.int32)[:, None] * BLOCK
    qpos = blk + jnp.arange(BLOCK, dtype=jnp.int32)[None, :]
    kpos = blk - pad + jnp.arange(n_keys, dtype=jnp.int32)[None, :]
    valid = ((jnp.abs(qpos[:, :, None] - kpos[:, None, :]) <= WINDOW)
             & (kpos[:, None, :] >= 0) & (kpos[:, None, :] < s))
    scores = jnp.where(valid[None, :, None, None], scores, NEG_INF)
    sink_l = sink.astype(jnp.float32).reshape(N_KV_HEADS, GQA_GROUP)[None, None, :, :, None, None]
    m = jnp.maximum(jnp.max(scores, axis=-1, keepdims=True), sink_l)
    p = jnp.exp(scores - m)
    denom = jnp.sum(p, axis=-1, keepdims=True) + jnp.exp(sink_l - m)
    probs = (p / denom).astype(v.dtype)
    out = jnp.einsum('bngrqk,bnkgd->bnqgrd', probs, vb)
    return out.reshape(b, s, N_Q_HEADS * HEAD_DIM)


def _complex_linear_combine(e1, e2):
    a1r, a1i, b1r, b1i = e1
    a2r, a2i, b2r, b2i = e2
    return (a2r * a1r - a2i * a1i,
            a2r * a1i + a2i * a1r,
            a2r * b1r - a2i * b1i + b2r,
            a2r * b1i + a2i * b1r + b2i)


def s5_bidirectional(u, a_re, a_im, log_dt, b_re, b_im, c_re, c_im, d, w_glu, b_glu):
    bsz, s = u.shape[0], u.shape[1]
    uf = u.astype(jnp.float32)
    ug = uf.reshape(bsz, s, N_SSM_GROUPS, SSM_CH)
    y = d.astype(jnp.float32) * uf
    for direction in range(N_DIR):
        dt = jnp.exp(log_dt[direction].astype(jnp.float32))[:, None]
        ar = a_re[direction].astype(jnp.float32)
        ai = a_im[direction].astype(jnp.float32)
        mag = jnp.exp(dt * ar)
        lr = mag * jnp.cos(dt * ai)
        li = mag * jnp.sin(dt * ai)
        den = ar * ar + ai * ai
        fr = ((lr - 1.0) * ar + li * ai) / den
        fi = (li * ar - (lr - 1.0) * ai) / den
        br = b_re[direction].astype(jnp.float32)
        bi = b_im[direction].astype(jnp.float32)
        bbar_r = fr[:, :, None] * br - fi[:, :, None] * bi
        bbar_i = fr[:, :, None] * bi + fi[:, :, None] * br
        bu_r = jnp.einsum('bsgc,gpc->bsgp', ug, bbar_r)
        bu_i = jnp.einsum('bsgc,gpc->bsgp', ug, bbar_i)
        a_r = jnp.broadcast_to(lr[None, None], bu_r.shape)
        a_i = jnp.broadcast_to(li[None, None], bu_r.shape)
        _, _, xr, xi = lax.associative_scan(_complex_linear_combine, (a_r, a_i, bu_r, bu_i),
                                            reverse=(direction == 1), axis=1)
        cr = c_re[direction].astype(jnp.float32)
        ci = c_im[direction].astype(jnp.float32)
        yc = jnp.einsum('bsgp,gcp->bsgc', xr, cr) - jnp.einsum('bsgp,gcp->bsgc', xi, ci)
        y = y + yc.reshape(bsz, s, D_SSM)
    g = jax.nn.gelu(y)
    y = g * jax.nn.sigmoid(g @ w_glu.astype(jnp.float32) + b_glu.astype(jnp.float32))
    return y.astype(u.dtype)


def setup_inputs(seed: int = 0) -> dict:
    key = jax.random.key(seed)
    ks = jax.random.split(key, 20)
    n = jnp.arange(SSM_STATE, dtype=jnp.float32)
    shp_a = (DEPTH, N_DIR, N_SSM_GROUPS, SSM_STATE)
    shp_b = (DEPTH, N_DIR, N_SSM_GROUPS, SSM_STATE, SSM_CH)
    shp_c = (DEPTH, N_DIR, N_SSM_GROUPS, SSM_CH, SSM_STATE)
    return {
        "x": jax.random.normal(ks[0], (BATCH, SEQ, D_MODEL), jnp.float32),
        "w_in": jax.random.normal(ks[1], (DEPTH, D_MODEL, D_IN_PROJ), jnp.float32) * D_MODEL ** -0.5,
        "attn_sink": jax.random.normal(ks[2], (DEPTH, N_Q_HEADS), jnp.float32) * 0.5,
        "ssm_a_re": -0.5 + 0.01 * jax.random.normal(ks[3], shp_a, jnp.float32),
        "ssm_a_im": math.pi * n + 0.01 * jax.random.normal(ks[4], shp_a, jnp.float32),
        "ssm_log_dt": jax.random.uniform(ks[5], (DEPTH, N_DIR, N_SSM_GROUPS), jnp.float32,
                                         math.log(DT_MIN), math.log(DT_MAX)),
        "ssm_b_re": jax.random.normal(ks[6], shp_b, jnp.float32) * (2.0 * SSM_CH) ** -0.5,
        "ssm_b_im": jax.random.normal(ks[7], shp_b, jnp.float32) * (2.0 * SSM_CH) ** -0.5,
        "ssm_c_re": jax.random.normal(ks[8], shp_c, jnp.float32) * (2.0 * SSM_STATE) ** -0.5,
        "ssm_c_im": jax.random.normal(ks[9], shp_c, jnp.float32) * (2.0 * SSM_STATE) ** -0.5,
        "ssm_d": jax.random.normal(ks[10], (DEPTH, D_SSM), jnp.float32),
        "w_glu": jax.random.normal(ks[11], (DEPTH, D_SSM, D_SSM), jnp.float32) * D_SSM ** -0.5,
        "b_glu": 0.01 * jax.random.normal(ks[12], (DEPTH, D_SSM), jnp.float32),
        "norm_attn_g": 1.0 + 0.01 * jax.random.normal(ks[13], (DEPTH, D_ATTN), jnp.float32),
        "norm_ssm_g": 1.0 + 0.01 * jax.random.normal(ks[14], (DEPTH, D_SSM), jnp.float32),
        "w_out": jax.random.normal(ks[15], (DEPTH, D_MIX, D_MODEL), jnp.float32) * (D_MIX ** -0.5) * DEEPNORM_BETA,
        "ln_g": 1.0 + 0.01 * jax.random.normal(ks[16], (DEPTH, D_MODEL), jnp.float32),
        "ln_b": 0.01 * jax.random.normal(ks[17], (DEPTH, D_MODEL), jnp.float32),
    }


def reference(x, w_in, attn_sink, ssm_a_re, ssm_a_im, ssm_log_dt, ssm_b_re, ssm_b_im, ssm_c_re, ssm_c_im,
              ssm_d, w_glu, b_glu, norm_attn_g, norm_ssm_g, w_out, ln_g, ln_b):
    bsz, s = x.shape[0], x.shape[1]
    pos = jnp.arange(s, dtype=jnp.int32)
    h = x
    for l in range(DEPTH):
        proj = h @ w_in[l]
        q, k, v, z_attn, u, z_ssm = jnp.split(proj, SPLITS, axis=-1)
        q = rope(q.reshape(bsz, s, N_Q_HEADS, HEAD_DIM), pos)
        k = rope(k.reshape(bsz, s, N_KV_HEADS, HEAD_DIM), pos)
        v = v.reshape(bsz, s, N_KV_HEADS, HEAD_DIM)
        y_attn = windowed_gqa_with_sink(q, k, v, attn_sink[l]) * jax.nn.silu(z_attn)
        y_attn = rms_norm(y_attn, norm_attn_g[l])
        y_ssm = s5_bidirectional(u, ssm_a_re[l], ssm_a_im[l], ssm_log_dt[l], ssm_b_re[l], ssm_b_im[l],
                                 ssm_c_re[l], ssm_c_im[l], ssm_d[l], w_glu[l], b_glu[l]) * jax.nn.silu(z_ssm)
        y_ssm = rms_norm(y_ssm, norm_ssm_g[l])
        mixed = jnp.concatenate([y_attn, y_ssm], axis=-1)
        h = layer_norm(DEEPNORM_ALPHA * h + mixed @ w_out[l], ln_g[l], ln_b[l])
    return h
```

```cpp
#include <hip/hip_runtime.h>
#include <hip/hip_cooperative_groups.h>
#include <cstdint>
#include <cstdio>
namespace cg = cooperative_groups;

#ifndef N_LAUNCH_MODE
#define N_LAUNCH_MODE 0
#endif

typedef unsigned short bf16_t;
typedef short bf16x8 __attribute__((ext_vector_type(8)));
typedef float f32x16 __attribute__((ext_vector_type(16)));
typedef float f32x4 __attribute__((ext_vector_type(4)));
typedef float f32x2 __attribute__((ext_vector_type(2)));
typedef unsigned u32x4 __attribute__((ext_vector_type(4)));
typedef unsigned u32x2 __attribute__((ext_vector_type(2)));
#define LAS __attribute__((address_space(3)))

constexpr int NT = 512;
constexpr int SEQ = 4096, DM = 1024, MTOK = 16384, NPROJ = 2304;
constexpr float LOG2E = 1.4426950408889634f;
constexpr float QSCALE = 0.125f * LOG2E;
constexpr float NORM_EPS = 1e-5f;
constexpr float DN_ALPHA = 1.189207115002721f;

constexpr size_t WS_BAR = 0;
constexpr size_t WS_CNT = 16384;
constexpr size_t WS_WINT = 32768;
constexpr size_t WS_WGLUT = WS_WINT + (size_t)2304 * 1024 * 2;
constexpr size_t WS_WOUTT = WS_WGLUT + (size_t)512 * 512 * 2;
constexpr size_t WS_ROPE = WS_WOUTT + (size_t)1024 * 1024 * 2;
constexpr size_t WS_LAM = WS_ROPE + (size_t)4096 * 32 * 8;
constexpr size_t WS_WS = WS_LAM + 65536;
constexpr size_t WS_TW = WS_WS + (size_t)32 * 256 * 256 * 2;
constexpr size_t WS_XB = WS_TW + (size_t)32 * 256 * 512 * 2;
constexpr size_t WS_S = WS_XB;
constexpr size_t WS_Q = WS_XB + (size_t)16384 * 1024 * 2;
constexpr size_t WS_K = WS_Q + (size_t)16384 * 512 * 2;
constexpr size_t WS_VT = WS_K + (size_t)16384 * 128 * 2;
constexpr size_t WS_ZA = WS_VT + (size_t)16384 * 128 * 2;
constexpr size_t WS_UG = WS_ZA + (size_t)16384 * 512 * 2;
constexpr size_t WS_ZS = WS_UG + (size_t)16384 * 512 * 2;
constexpr size_t WS_XIN = WS_ZS + (size_t)16384 * 512 * 2;
constexpr size_t WS_G = WS_XIN + (size_t)32 * 1024 * 256 * 2;
constexpr size_t WS_YA = WS_G + (size_t)16384 * 512 * 2;
constexpr size_t WS_YS = WS_YA + (size_t)16384 * 512 * 2;
constexpr size_t WS_SSQA = WS_YS + (size_t)16384 * 512 * 2;
constexpr size_t WS_SSQS = WS_SSQA + (size_t)16384 * 8 * 4;
constexpr size_t WS_LNST = WS_SSQS + (size_t)16384 * 8 * 4;
constexpr size_t WS_END = WS_LNST + (size_t)16384 * 16 * 2 * 4;

__device__ __forceinline__ unsigned pk_bf16(float lo, float hi) { unsigned r; asm("v_cvt_pk_bf16_f32 %0, %1, %2" : "=v"(r) : "v"(lo), "v"(hi)); return r; }
__device__ __forceinline__ bf16_t to_bf16(float v) { return (bf16_t)(pk_bf16(v, 0.f) & 0xffffu); }
__device__ __forceinline__ float bf_lo(unsigned w) { return __uint_as_float(w << 16); }
__device__ __forceinline__ float bf_hi(unsigned w) { return __uint_as_float(w & 0xffff0000u); }
__device__ __forceinline__ float fast_exp2(float x) { return __builtin_amdgcn_exp2f(x); }
__device__ __forceinline__ float sigmoidf_(float x) { return 1.0f / (1.0f + __expf(-x)); }
__device__ __forceinline__ float siluf_(float x) { return x * sigmoidf_(x); }
__device__ __forceinline__ float gelu_tanh(float x) {
    const float z = 0.7978845608028654f * (x + 0.044715f * x * x * x);
    const float t = 1.0f - 2.0f / (__expf(2.0f * z) + 1.0f);
    return 0.5f * x * (1.0f + t);
}
#define MFMA32(a, b, c) __builtin_amdgcn_mfma_f32_32x32x16_bf16((a), (b), (c), 0, 0, 0)

#define XB_TMO      128
#define XB_XCNT(j)  (256  + 64 * (j))
#define XB_XSUB(j)  (1280 + 64 * (j))
#define XB_XGEN(j)  (2304 + 64 * (j))
#define XB_TOP      3328
#define XB_TOPGEN   3392
#define XCD_BAR_WORDS 3456
#define XB_SPIN_CAP (1u << 22)
__device__ __forceinline__ unsigned xb_ld(unsigned* p)              { return __hip_atomic_load(p, __ATOMIC_RELAXED, __HIP_MEMORY_SCOPE_AGENT); }
__device__ __forceinline__ unsigned xb_add(unsigned* p, unsigned v) { return __hip_atomic_fetch_add(p, v, __ATOMIC_RELAXED, __HIP_MEMORY_SCOPE_AGENT); }
__device__ __forceinline__ unsigned xb_xcc_id() { return (unsigned)__builtin_amdgcn_s_getreg((3 << 11) | 20) & 0xFu; }
#define XB_SPIN(cond, bar) do { unsigned _sp = 0; while (cond) { __builtin_amdgcn_s_sleep(1); \
    if ((++_sp & 255u) == 0u) { if (xb_ld(&(bar)[XB_TMO])) break; if (_sp > XB_SPIN_CAP) { atomicAdd(&(bar)[XB_TMO], 1u); break; } } } } while (0)
struct XcdBarrier { unsigned* bar; unsigned x; volatile LAS unsigned* st; };
__device__ __forceinline__ XcdBarrier xcd_barrier_post(unsigned* bar, volatile LAS unsigned* st) {
    XcdBarrier b; b.bar = bar; b.x = xb_xcc_id(); b.st = st;
    if (threadIdx.x == 0) (void)xb_add(&bar[XB_XCNT(b.x)], 1u);
    return b;
}
__device__ __forceinline__ void xcd_barrier_complete(unsigned* bar, unsigned x, unsigned& nloc, unsigned& nx) {
    const unsigned G = gridDim.x * gridDim.y * gridDim.z;
    unsigned sum, cnt, mine, sp = 0u;
    for (;;) {
        sum = 0u; cnt = 0u; mine = 0u;
#pragma unroll
        for (unsigned j = 0; j < 16; ++j) { const unsigned c = xb_ld(&bar[XB_XCNT(j)]); sum += c; cnt += (c > 0u) ? 1u : 0u; mine = (j == x) ? c : mine; }
        if (sum == G) break;
        __builtin_amdgcn_s_sleep(1);
        if ((++sp & 255u) == 0u) { if (xb_ld(&bar[XB_TMO])) break; if (sp > XB_SPIN_CAP) { atomicAdd(&bar[XB_TMO], 1u); break; } }
    }
    nloc = mine > 0u ? mine : 1u; nx = cnt > 0u ? cnt : 1u;
}
__device__ __forceinline__ void xcd_barrier(const XcdBarrier& b) {
    asm volatile("s_waitcnt vmcnt(0)" ::: "memory");
    __syncthreads();
    if (threadIdx.x == 0) {
        unsigned* bar = b.bar;
        __builtin_amdgcn_s_waitcnt(0);
        unsigned nloc = b.st[0], nx = b.st[1];
        if (nloc == 0u) { xcd_barrier_complete(bar, b.x, nloc, nx); b.st[0] = nloc; b.st[1] = nx; }
        const unsigned old = xb_add(&bar[XB_XSUB(b.x)], 1u);
        const unsigned gen = old / nloc;
        if (old + 1u == (gen + 1u) * nloc) {
            __builtin_amdgcn_fence(__ATOMIC_RELEASE, "agent");
            asm volatile("s_waitcnt vmcnt(0)" ::: "memory");
            const unsigned og = xb_add(&bar[XB_TOP], 1u);
            const unsigned tg = og / nx;
            if (og + 1u == (tg + 1u) * nx) xb_add(&bar[XB_TOPGEN], 1u);
            else XB_SPIN(xb_ld(&bar[XB_TOPGEN]) == tg, bar);
            __builtin_amdgcn_fence(__ATOMIC_ACQUIRE, "agent");
            xb_add(&bar[XB_XGEN(b.x)], 1u);
            asm volatile("s_waitcnt vmcnt(0)" ::: "memory");
        } else {
            XB_SPIN(xb_ld(&bar[XB_XGEN(b.x)]) == gen, bar);
            __builtin_amdgcn_fence(__ATOMIC_ACQUIRE, "agent");
            asm volatile("s_waitcnt vmcnt(0)" ::: "memory");
        }
    }
    __syncthreads();
}

struct Args { const float* in[18]; float* out; unsigned char* ws; int ph_lo, ph_hi, never, pad; };

constexpr int BM = 256, BN = 128, BK = 64;
constexpr int ROWB = 144;
constexpr int A_STAGE = BM * 128, B_STAGE = BN * 128, STAGE = A_STAGE + B_STAGE;
constexpr int LDS_MAIN = 3 * STAGE;
constexpr int SLDS_ROW = 528;
constexpr int LDS_SCAN_E = 256 * SLDS_ROW;
constexpr int LDS_MAIN2 = LDS_MAIN > (LDS_SCAN_E + 4096) ? LDS_MAIN : (LDS_SCAN_E + 4096);
constexpr int LDS_BYTES = LDS_MAIN2 + 64;

template <class Epi, bool MID>
__device__ __forceinline__ void gemm_tile(LAS unsigned char* lds, const bf16_t* __restrict__ A0, int lda0, const bf16_t* __restrict__ A1, int lda1, int ksplit,
                                          const bf16_t* __restrict__ Bt, int ldb, int K, int m0, int n0, const Epi& epi) {
    int tid = threadIdx.x; asm volatile("" : "+v"(tid));
    const int lane = tid & 63, wid = __builtin_amdgcn_readfirstlane(tid >> 6);
    const int wm = wid >> 1, wn = wid & 1, r32 = lane & 31, h = lane >> 5;
    const int grow = lane >> 3, gc = lane & 7;
    const int csrc = (gc ^ (((wid * 8 + grow) >> 1) & 7)) * 8;
    const int rs_ = (wid * 8 + grow) & 31, rperm = 16 * ((rs_ >> 2) & 1) + 4 * (rs_ >> 3) + (rs_ & 3);
    const size_t arow = (size_t)(m0 + wid * 8 + grow), brow = (size_t)(n0 + ((wid * 8 + grow) & ~31) + rperm);
    f32x16 acc[2][2];
#pragma unroll
    for (int i = 0; i < 2; ++i)
#pragma unroll
        for (int j = 0; j < 2; ++j)
#pragma unroll
            for (int r = 0; r < 16; ++r) acc[i][j][r] = 0.f;
    const int nt = K / BK;
#define GT_STAGE(kt, buf) do { const int _k0 = (kt) * BK; const bf16_t* _ab; int _ld, _kk; \
        if (_k0 < ksplit) { _ab = A0; _ld = lda0; _kk = _k0; } else { _ab = A1; _ld = lda1; _kk = _k0 - ksplit; } \
        const bf16_t* _ga = _ab + arow * _ld + _kk + csrc; const bf16_t* _gb = Bt + brow * ldb + _k0 + csrc; \
        LAS unsigned char* _la = lds + (buf) * STAGE + wid * 1024; \
        _Pragma("unroll") for (int _i = 0; _i < 4; ++_i) __builtin_amdgcn_global_load_lds((const unsigned*)(_ga + (size_t)_i * 64 * _ld), (LAS unsigned*)(_la + _i * 8192), 16, 0, 0); \
        _Pragma("unroll") for (int _i = 0; _i < 2; ++_i) __builtin_amdgcn_global_load_lds((const unsigned*)(_gb + (size_t)_i * 64 * ldb), (LAS unsigned*)(_la + A_STAGE + _i * 8192), 16, 0, 0); } while (0)
    const int swz = (r32 >> 1) & 7;
    const int o0 = ((0 + h) ^ swz) << 4, o1 = ((2 + h) ^ swz) << 4, o2 = ((4 + h) ^ swz) << 4, o3 = ((6 + h) ^ swz) << 4;
    int bcur = 0, bnxt = STAGE, bnn = 2 * STAGE;
    GT_STAGE(0, 0);
    if (nt > 1) GT_STAGE(1, 1);
    for (int kt = 0; kt < nt; ++kt) {
        if (kt + 1 < nt) asm volatile("s_waitcnt vmcnt(6)" ::: "memory"); else asm volatile("s_waitcnt vmcnt(0)" ::: "memory");
        __builtin_amdgcn_s_barrier();
        asm volatile("" ::: "memory");
        const bool st = (kt + 2 < nt);
        const bf16_t* _ga; const bf16_t* _gb; int _ld = lda0;
        {
            const int _k0 = (kt + 2) * BK; const bf16_t* _ab; int _kk;
            if (_k0 < ksplit) { _ab = A0; _ld = lda0; _kk = _k0; } else { _ab = A1; _ld = lda1; _kk = _k0 - ksplit; }
            _ga = _ab + arow * _ld + _kk + csrc; _gb = Bt + brow * ldb + _k0 + csrc;
        }
        LAS unsigned char* _la = lds + bnn + wid * 1024;
        if constexpr (MID) { if (kt * BK == ksplit) epi.mid(acc, m0 + wm * 64 + r32); }
        const LAS unsigned char* sa = lds + bcur + (wm * 64 + r32) * 128;
        const LAS unsigned char* sb = lds + bcur + A_STAGE + (wn * 64 + r32) * 128;
#define GT_LD(A0_, A1_, B0_, B1_, off) do { A0_ = *(const LAS bf16x8*)(sa + (off)); A1_ = *(const LAS bf16x8*)(sa + 32 * 128 + (off)); \
            B0_ = *(const LAS bf16x8*)(sb + (off)); B1_ = *(const LAS bf16x8*)(sb + 32 * 128 + (off)); } while (0)
#define GT_MM(A0_, A1_, B0_, B1_) do { acc[0][0] = MFMA32(B0_, A0_, acc[0][0]); acc[0][1] = MFMA32(B1_, A0_, acc[0][1]); \
            acc[1][0] = MFMA32(B0_, A1_, acc[1][0]); acc[1][1] = MFMA32(B1_, A1_, acc[1][1]); } while (0)
        bf16x8 xa0, xa1, xb0, xb1, ya0, ya1, yb0, yb1;
        GT_LD(xa0, xa1, xb0, xb1, o0);
        GT_LD(ya0, ya1, yb0, yb1, o1);
        GT_MM(xa0, xa1, xb0, xb1);
        __builtin_amdgcn_sched_barrier(0);
        if (st) { __builtin_amdgcn_global_load_lds((const unsigned*)(_ga), (LAS unsigned*)(_la), 16, 0, 0);
                  __builtin_amdgcn_global_load_lds((const unsigned*)(_ga + (size_t)64 * _ld), (LAS unsigned*)(_la + 8192), 16, 0, 0); }
        GT_LD(xa0, xa1, xb0, xb1, o2);
        __builtin_amdgcn_sched_barrier(0);
        GT_MM(ya0, ya1, yb0, yb1);
        __builtin_amdgcn_sched_barrier(0);
        if (st) { __builtin_amdgcn_global_load_lds((const unsigned*)(_ga + (size_t)128 * _ld), (LAS unsigned*)(_la + 2 * 8192), 16, 0, 0);
                  __builtin_amdgcn_global_load_lds((const unsigned*)(_ga + (size_t)192 * _ld), (LAS unsigned*)(_la + 3 * 8192), 16, 0, 0); }
        GT_LD(ya0, ya1, yb0, yb1, o3);
        __builtin_amdgcn_sched_barrier(0);
        GT_MM(xa0, xa1, xb0, xb1);
        __builtin_amdgcn_sched_barrier(0);
        if (st) { __builtin_amdgcn_global_load_lds((const unsigned*)(_gb), (LAS unsigned*)(_la + A_STAGE), 16, 0, 0);
                  __builtin_amdgcn_global_load_lds((const unsigned*)(_gb + (size_t)64 * ldb), (LAS unsigned*)(_la + A_STAGE + 8192), 16, 0, 0); }
        __builtin_amdgcn_sched_barrier(0);
        GT_MM(ya0, ya1, yb0, yb1);
#undef GT_LD
#undef GT_MM
        { const int t_ = bcur; bcur = bnxt; bnxt = bnn; bnn = t_; }
    }
    asm volatile("" ::: "memory");
    __builtin_amdgcn_s_barrier();
    asm volatile("" ::: "memory");
#undef GT_STAGE
    epi.run(acc, m0 + wm * 64, n0 + wn * 64, r32, h);
}

struct EpiProj {
    bf16_t *Q, *Kk, *VT, *Za, *Ug, *Zs; const float* rope;
    __device__ __forceinline__ void run(const f32x16 (&acc)[2][2], int mrow0, int ncol0, int r32, int h) const {
#pragma unroll
        for (int mi = 0; mi < 2; ++mi) {
            const int row = mrow0 + mi * 32 + r32, t = row & 4095;
#pragma unroll
            for (int ni = 0; ni < 2; ++ni) {
#pragma unroll
                for (int q = 0; q < 4; ++q) {
                    const int col = ncol0 + ni * 32 + q * 8 + h * 4;
                    float v0 = acc[mi][ni][4 * q], v1 = acc[mi][ni][4 * q + 1], v2 = acc[mi][ni][4 * q + 2], v3 = acc[mi][ni][4 * q + 3];
                    if (ncol0 < 640) {
                        const int i0 = (col & 63) >> 1;
                        const f32x4 cs = *(const f32x4*)(rope + ((size_t)t * 32 + i0) * 2);
                        float o0 = v0 * cs[0] - v1 * cs[1], o1 = v1 * cs[0] + v0 * cs[1], o2 = v2 * cs[2] - v3 * cs[3], o3 = v3 * cs[2] + v2 * cs[3];
                        if (ncol0 < 512) { u32x2 w; w.x = pk_bf16(o0 * QSCALE, o1 * QSCALE); w.y = pk_bf16(o2 * QSCALE, o3 * QSCALE); *(u32x2*)(Q + (size_t)row * 512 + col) = w; }
                        else { u32x2 w; w.x = pk_bf16(o0, o1); w.y = pk_bf16(o2, o3); *(u32x2*)(Kk + (size_t)row * 128 + (col - 512)) = w; }
                    } else if (ncol0 < 768) {
                        const int c = col - 640, b = row >> 12;
                        bf16_t* p = VT + ((size_t)(b * 128 + c)) * 4096 + t;
                        p[0] = to_bf16(v0); p[4096] = to_bf16(v1); p[8192] = to_bf16(v2); p[12288] = to_bf16(v3);
                    } else {
                        u32x2 w; w.x = pk_bf16(v0, v1); w.y = pk_bf16(v2, v3);
                        if (ncol0 < 1280) *(u32x2*)(Za + (size_t)row * 512 + (col - 768)) = w;
                        else if (ncol0 < 1792) { const int c = col - 1280; *(u32x2*)(Ug + ((size_t)(c >> 4) * 16384 + row) * 16 + (c & 15)) = w; }
                        else *(u32x2*)(Zs + (size_t)row * 512 + (col - 1792)) = w;
                    }
                }
            }
        }
    }
};
struct EpiSScan {
    LAS unsigned char* lds; const float* lam; bf16_t* Xin; int g, b, dir;
    __device__ __forceinline__ void run(const f32x16 (&acc)[2][2], int mrow0, int ncol0, int r32, int h) const {
        const int lrow0 = mrow0 - b * 256, lcol0 = ncol0 - dir * 128;
#pragma unroll
        for (int mi = 0; mi < 2; ++mi) {
            const int row = lrow0 + mi * 32 + r32;
#pragma unroll
            for (int ni = 0; ni < 2; ++ni)
#pragma unroll
                for (int q = 0; q < 4; ++q) {
                    const int col = lcol0 + ni * 32 + 16 * h + 4 * q;
                    *(LAS f32x4*)(lds + row * SLDS_ROW + col * 4) = (f32x4){acc[mi][ni][4 * q], acc[mi][ni][4 * q + 1], acc[mi][ni][4 * q + 2], acc[mi][ni][4 * q + 3]};
                }
        }
        __syncthreads();
        int tid = threadIdx.x; asm volatile("" : "+v"(tid));
        const int seg = __builtin_amdgcn_readfirstlane(tid >> 6), p = tid & 63;
        LAS f32x2* E = (LAS f32x2*)(lds + LDS_SCAN_E);
        const f32x2 lm = *(const f32x2*)(lam + ((size_t)(g * 2 + dir) * 64 + p) * 2);
        const f32x2 lm32 = *(const f32x2*)(lam + 8192 + ((size_t)(g * 2 + dir) * 64 + p) * 2);
        const LAS unsigned char* Sp = lds + p * 8;
        bf16_t* Xp = Xin + ((size_t)g * 1024 + b * 256) * 256 + dir * 128 + 2 * p;
        float er = 0.f, ei = 0.f;
#pragma unroll 8
        for (int i = 0; i < 32; ++i) {
            const int c = dir == 0 ? seg * 32 + i : seg * 32 + 31 - i;
            const f32x2 sv = *(const LAS f32x2*)(Sp + c * SLDS_ROW);
            const float nr = lm.x * er - lm.y * ei + sv.x, ni = lm.x * ei + lm.y * er + sv.y;
            er = nr; ei = ni;
        }
        E[seg * 64 + p] = (f32x2){er, ei};
        __syncthreads();
        float cr = 0.f, ci = 0.f;
        if (dir == 0) { for (int s2 = 0; s2 < seg; ++s2) { const f32x2 e = E[s2 * 64 + p]; const float nr = lm32.x * cr - lm32.y * ci + e.x, ni = lm32.x * ci + lm32.y * cr + e.y; cr = nr; ci = ni; } }
        else { for (int s2 = 7; s2 > seg; --s2) { const f32x2 e = E[s2 * 64 + p]; const float nr = lm32.x * cr - lm32.y * ci + e.x, ni = lm32.x * ci + lm32.y * cr + e.y; cr = nr; ci = ni; } }
#pragma unroll 8
        for (int i = 0; i < 32; ++i) {
            const int c = dir == 0 ? seg * 32 + i : seg * 32 + 31 - i;
            const f32x2 sv = *(const LAS f32x2*)(Sp + c * SLDS_ROW);
            *(unsigned*)(Xp + (size_t)c * 256) = pk_bf16(cr, ci);
            const float nr = lm.x * cr - lm.y * ci + sv.x, ni = lm.x * ci + lm.y * cr + sv.y;
            cr = nr; ci = ni;
        }
        __syncthreads();
    }
};
struct EpiY {
    bf16_t* G; int g;
    __device__ __forceinline__ void run(const f32x16 (&acc)[2][2], int mrow0, int ncol0, int r32, int h) const {
#pragma unroll
        for (int mi = 0; mi < 2; ++mi) {
            const int row = mrow0 + mi * 32 + r32;
#pragma unroll
            for (int ni = 0; ni < 2; ++ni) {
                const int pos = (ncol0 + ni * 32 + 16 * h) >> 4;
                unsigned w[8];
#pragma unroll
                for (int e = 0; e < 8; ++e) w[e] = pk_bf16(gelu_tanh(acc[mi][ni][2 * e]), gelu_tanh(acc[mi][ni][2 * e + 1]));
                bf16_t* p = G + ((size_t)row * 16 + pos) * 512 + g * 16;
                *(u32x4*)p = (u32x4){w[0], w[1], w[2], w[3]}; *(u32x4*)(p + 8) = (u32x4){w[4], w[5], w[6], w[7]};
            }
        }
    }
};
struct EpiGlu {
    const bf16_t *G, *Zs; const float* bglu; bf16_t* Ys; float* ssqS;
    __device__ __forceinline__ void run(const f32x16 (&acc)[2][2], int mrow0, int ncol0, int r32, int h) const {
#pragma unroll
        for (int mi = 0; mi < 2; ++mi) {
            const int row = mrow0 + mi * 32 + r32; float ssq = 0.f;
#pragma unroll
            for (int ni = 0; ni < 2; ++ni) {
                const int col = ncol0 + ni * 32 + 16 * h;
                const u32x4 g0 = *(const u32x4*)(G + (size_t)row * 512 + col), g1 = *(const u32x4*)(G + (size_t)row * 512 + col + 8);
                const u32x4 z0 = *(const u32x4*)(Zs + (size_t)row * 512 + col), z1 = *(const u32x4*)(Zs + (size_t)row * 512 + col + 8);
                const unsigned gg[8] = {g0.x, g0.y, g0.z, g0.w, g1.x, g1.y, g1.z, g1.w}, zz[8] = {z0.x, z0.y, z0.z, z0.w, z1.x, z1.y, z1.z, z1.w};
                unsigned w[8];
#pragma unroll
                for (int e = 0; e < 8; ++e) {
                    const f32x2 bb = *(const f32x2*)(bglu + col + 2 * e);
                    const float y0 = bf_lo(gg[e]) * sigmoidf_(acc[mi][ni][2 * e] + bb.x) * siluf_(bf_lo(zz[e]));
                    const float y1 = bf_hi(gg[e]) * sigmoidf_(acc[mi][ni][2 * e + 1] + bb.y) * siluf_(bf_hi(zz[e]));
                    ssq += y0 * y0 + y1 * y1;
                    w[e] = pk_bf16(y0, y1);
                }
                *(u32x4*)(Ys + (size_t)row * 512 + col) = (u32x4){w[0], w[1], w[2], w[3]}; *(u32x4*)(Ys + (size_t)row * 512 + col + 8) = (u32x4){w[4], w[5], w[6], w[7]};
            }
            ssq += __shfl_xor(ssq, 32);
            if (h == 0) ssqS[(size_t)row * 8 + (ncol0 >> 6)] = ssq;
        }
    }
};
__device__ __forceinline__ float rstd8(const float* p) {
    const f32x4 a = *(const f32x4*)p, b = *(const f32x4*)(p + 4);
    const float s = ((a[0] + a[1]) + (a[2] + a[3])) + ((b[0] + b[1]) + (b[2] + b[3]));
    return 1.0f / sqrtf(s * (1.0f / 512.0f) + NORM_EPS);
}
struct EpiOut {
    const float *x, *ssqA, *ssqS, *ln_g, *ln_b; float* out; unsigned long long* lnst; unsigned* cnt; unsigned target;
    __device__ __forceinline__ void mid(f32x16 (&acc)[2][2], int rowbase) const {
#pragma unroll
        for (int mi = 0; mi < 2; ++mi) {
            const int row = rowbase + mi * 32;
            const float f = rstd8(ssqA + (size_t)row * 8) / rstd8(ssqS + (size_t)row * 8);
#pragma unroll
            for (int ni = 0; ni < 2; ++ni)
#pragma unroll
                for (int r = 0; r < 16; ++r) acc[mi][ni][r] *= f;
        }
    }
    __device__ __forceinline__ void run(f32x16 (&acc)[2][2], int mrow0, int ncol0, int r32, int h) const {
#pragma unroll
        for (int mi = 0; mi < 2; ++mi) {
            const int row = mrow0 + mi * 32 + r32;
            const float rs = rstd8(ssqS + (size_t)row * 8);
            float sum = 0.f, sq = 0.f;
#pragma unroll
            for (int ni = 0; ni < 2; ++ni)
#pragma unroll
                for (int q = 0; q < 4; ++q) {
                    const int col = ncol0 + ni * 32 + q * 8 + h * 4;
                    const f32x4 xv = *(const f32x4*)(x + (size_t)row * 1024 + col);
#pragma unroll
                    for (int j = 0; j < 4; ++j) { const float hv = DN_ALPHA * xv[j] + acc[mi][ni][4 * q + j] * rs; acc[mi][ni][4 * q + j] = hv; sum += hv; sq += hv * hv; }
                }
            sum += __shfl_xor(sum, 32); sq += __shfl_xor(sq, 32);
            if (h == 0) __hip_atomic_store(lnst + (size_t)row * 16 + (ncol0 >> 6), ((unsigned long long)__float_as_uint(sq) << 32) | __float_as_uint(sum), __ATOMIC_RELAXED, __HIP_MEMORY_SCOPE_AGENT);
        }
        asm volatile("s_waitcnt vmcnt(0)" ::: "memory");
        if ((threadIdx.x & 63) == 0) __hip_atomic_fetch_add(cnt, 1u, __ATOMIC_RELAXED, __HIP_MEMORY_SCOPE_AGENT);
        { unsigned sp = 0; while (__hip_atomic_load(cnt, __ATOMIC_RELAXED, __HIP_MEMORY_SCOPE_AGENT) < target) { __builtin_amdgcn_s_sleep(2); if (++sp > (1u << 24)) break; } }
        asm volatile("" ::: "memory");
#pragma unroll
        for (int mi = 0; mi < 2; ++mi) {
            const int row = mrow0 + mi * 32 + r32;
            float sum = 0.f, sq = 0.f;
#pragma unroll
            for (int t = 0; t < 16; ++t) { const unsigned long long w = __hip_atomic_load(lnst + (size_t)row * 16 + t, __ATOMIC_RELAXED, __HIP_MEMORY_SCOPE_AGENT); sum += __uint_as_float((unsigned)w); sq += __uint_as_float((unsigned)(w >> 32)); }
            const float mean = sum * (1.0f / 1024.0f);
            const float var = fmaxf(sq * (1.0f / 1024.0f) - mean * mean, 0.f);
            const float rstd = 1.0f / sqrtf(var + NORM_EPS);
#pragma unroll
            for (int ni = 0; ni < 2; ++ni)
#pragma unroll
                for (int q = 0; q < 4; ++q) {
                    const int col = ncol0 + ni * 32 + q * 8 + h * 4;
                    const f32x4 gg = *(const f32x4*)(ln_g + col), bb = *(const f32x4*)(ln_b + col);
                    f32x4 o;
#pragma unroll
                    for (int j = 0; j < 4; ++j) o[j] = (acc[mi][ni][4 * q + j] - mean) * rstd * gg[j] + bb[j];
                    *(f32x4*)(out + (size_t)row * 1024 + col) = o;
                }
        }
    }
};


typedef float f32x4v __attribute__((ext_vector_type(4)));
constexpr int HTB = 128 * 64 * 2;
constexpr int LDS8_TAB = 8 * HTB;
__host__ __device__ __forceinline__ int lds_byte8(int r, int c) { const int st = (r >> 4) * 2 + (c >> 5), rr = r & 15, cc = c & 31, ob = rr * 64 + cc * 2; return st * 1024 + (ob ^ (((ob >> 9) & 1) << 5)); }
__host__ __device__ __forceinline__ void stage_rc8(int b, int& R, int& C) { const int st = b / 1024, sb = b % 1024, swz = sb ^ (((sb >> 9) & 1) << 5); R = (st >> 1) * 16 + swz / 64; C = (st & 1) * 32 + (swz % 64) / 2; }
#define MFMA16(a, b, c) __builtin_amdgcn_mfma_f32_16x16x32_bf16((a), (b), (c), 0, 0, 0)

__host__ __device__ __forceinline__ int perm32_8(int rho) { const int n = rho >> 4, i = rho & 15; return 8 * (i >> 2) + 4 * n + (i & 3); }
template <class Epi, class Sched, bool MID, bool AFTER_DRAIN, bool SP2>
__device__ __forceinline__ void gemm8_phase(LAS unsigned char* lds, const bf16_t* __restrict__ A0, const bf16_t* __restrict__ A1, int lda, int ksw,
                                            const bf16_t* __restrict__ Bt, int ldb, int nt, const Sched& S, const Epi& epi) {
    int tid = threadIdx.x; asm volatile("" : "+v"(tid));
    const int lane = tid & 63, wid = __builtin_amdgcn_readfirstlane(tid >> 6), wr = wid >> 2, wc = wid & 3, fr = lane & 15, fq = lane >> 4;
    int brow, bcol;
    if (!S.get(0, brow, bcol)) return;
    unsigned voffA[2], voffB[2];
#pragma unroll
    for (int i = 0; i < 2; ++i) { int R, C; stage_rc8(tid * 16 + i * 8192, R, C); const int Rb = Epi::PERM ? ((R & ~31) + perm32_8(R & 31)) : R; voffA[i] = (unsigned)(R * lda + C) * 2u; voffB[i] = (unsigned)(Rb * ldb + C) * 2u; }
    const unsigned ldsw = (unsigned)wid * 1024u;
    const int aoff = lds_byte8(wr * 64 + fr, fq * 8), boff = lds_byte8(wc * 32 + fr, fq * 8);
    const size_t hA = (size_t)128 * lda * 2, hB = (size_t)128 * ldb * 2;
    const char* cA0 = (const char*)A0 + (size_t)brow * lda * 2; const char* cA1 = (const char*)A1 + (size_t)brow * lda * 2;
    const char* cB = (const char*)Bt + (size_t)bcol * ldb * 2;
#define G8_SA(b, h) (((b) * 2 + (h)) * HTB)
#define G8_SB(b, h) ((4 + (b) * 2 + (h)) * HTB)
#define G8_AB(kt) ((kt) < ksw ? cA0 + (size_t)(kt) * 128 : cA1 + (size_t)((kt) - ksw) * 128)
#define G8_ST(off, gp, vo) do { const char* _g = (gp); _Pragma("unroll") for (int _i = 0; _i < 2; ++_i) \
        __builtin_amdgcn_global_load_lds((const unsigned*)(_g + vo[_i]), (LAS unsigned*)(lds + (off) + ldsw + _i * 8192), 16, 0, 0); } while (0)
#define G8_LDA(dst, b, h) do { _Pragma("unroll") for (int m = 0; m < 4; ++m) _Pragma("unroll") for (int k = 0; k < 2; ++k) dst[m][k] = *(const LAS bf16x8*)(lds + G8_SA(b, h) + aoff + m * 2048 + k * 1024); } while (0)
#define G8_LDB(dst, b, h) do { _Pragma("unroll") for (int n = 0; n < 2; ++n) _Pragma("unroll") for (int k = 0; k < 2; ++k) dst[n][k] = *(const LAS bf16x8*)(lds + G8_SB(b, h) + boff + n * 2048 + k * 1024); } while (0)
#define G8_MMA(ai, bj, At_, Bt_) do { __builtin_amdgcn_s_setprio(1); _Pragma("unroll") for (int m = 0; m < 4; ++m) _Pragma("unroll") for (int n = 0; n < 2; ++n) _Pragma("unroll") for (int k = 0; k < 2; ++k) \
        acc[ai][bj][m][n] = MFMA16(Bt_[n][k], At_[m][k], acc[ai][bj][m][n]); __builtin_amdgcn_s_setprio(0); } while (0)
#define G8_WV(n) asm volatile("s_waitcnt vmcnt(" #n ")" ::: "memory")
#define G8_WL(n) asm volatile("s_waitcnt lgkmcnt(" #n ")" ::: "memory")
#define G8_BAR __builtin_amdgcn_s_barrier()
#define G8_SCHED __builtin_amdgcn_sched_barrier(0)
    f32x4v acc[2][2][4][2];
#pragma unroll
    for (int a = 0; a < 2; ++a)
#pragma unroll
        for (int b = 0; b < 2; ++b)
#pragma unroll
            for (int m = 0; m < 4; ++m)
#pragma unroll
                for (int n = 0; n < 2; ++n) acc[a][b][m][n] = (f32x4v){0.f, 0.f, 0.f, 0.f};
    bf16x8 At[4][2], B0[2][2], B1[2][2];
    if constexpr (MID) epi.pre(brow, tid);
    if constexpr (SP2) {
        G8_ST(G8_SB(0, 0), cB, voffB); G8_ST(G8_SB(0, 1), cB + hB, voffB); G8_ST(G8_SA(0, 0), cA0, voffA); G8_ST(G8_SA(0, 1), cA0 + hA, voffA);
        if (wr == 1) G8_BAR;
        G8_WV(2); G8_BAR;
        G8_ST(G8_SB(1, 0), cB + 128, voffB); G8_ST(G8_SA(1, 0), G8_AB(1), voffA); G8_ST(G8_SB(1, 1), cB + 128 + hB, voffB);
        G8_WV(6); G8_BAR;
    } else {
    G8_ST(G8_SB(0, 0), cB, voffB); G8_ST(G8_SA(0, 0), cA0, voffA); G8_ST(G8_SB(0, 1), cB + hB, voffB); G8_ST(G8_SA(0, 1), cA0 + hA, voffA);
    if (wr == 1) G8_BAR;
    G8_WV(4); G8_BAR;
    G8_ST(G8_SB(1, 0), cB + 128, voffB); G8_ST(G8_SA(1, 0), G8_AB(1), voffA); G8_ST(G8_SB(1, 1), cB + 128 + hB, voffB);
    G8_WV(6); G8_BAR;
    }
    int ui = 0;
    for (;;) {
        int nbrow, nbcol; const bool has_next = S.get(ui + 1, nbrow, nbcol);
        const char* nA = has_next ? (const char*)A0 + (size_t)nbrow * lda * 2 : cA0; const char* nB = has_next ? (const char*)Bt + (size_t)nbcol * ldb * 2 : cB;
        for (int t = 0; t < nt; t += 2) {
            const bool last = (t == nt - 2);
            const char* a1 = G8_AB(t + 1);
            const char* a2 = last ? nA : G8_AB(t + 2); const char* b2 = last ? nB : cB + (size_t)(t + 2) * 128;
            const char* a3 = last ? nA + 128 : G8_AB(t + 3); const char* b3 = last ? nB + 128 : cB + (size_t)(t + 3) * 128;
            if constexpr (MID) { if (t == ksw) epi.mid(acc, wr * 64 + fr); }
            if constexpr (SP2) {
            G8_LDB(B0, 0, 0); G8_LDB(B1, 0, 1); G8_SCHED; G8_LDA(At, 0, 0); G8_ST(G8_SA(1, 1), a1 + hA, voffA);
            G8_WV(8); G8_WL(0); G8_BAR; G8_MMA(0, 0, At, B0); G8_MMA(0, 1, At, B1); G8_BAR; G8_SCHED;
            G8_LDA(At, 0, 1); G8_ST(G8_SB(0, 0), b2, voffB); G8_ST(G8_SB(0, 1), b2 + hB, voffB); G8_ST(G8_SA(0, 0), a2, voffA);
            G8_WV(8); G8_WL(0); G8_BAR; G8_MMA(1, 0, At, B0); G8_MMA(1, 1, At, B1); G8_BAR; G8_SCHED;
            G8_LDB(B0, 1, 0); G8_LDB(B1, 1, 1); G8_SCHED; G8_LDA(At, 1, 0); G8_ST(G8_SA(0, 1), a2 + hA, voffA);
            G8_WV(8); G8_WL(0); G8_BAR; G8_MMA(0, 0, At, B0); G8_MMA(0, 1, At, B1); G8_BAR; G8_SCHED;
            G8_LDA(At, 1, 1); G8_ST(G8_SB(1, 0), b3, voffB); G8_ST(G8_SB(1, 1), b3 + hB, voffB); G8_ST(G8_SA(1, 0), a3, voffA);
            G8_WV(8); G8_WL(0); G8_BAR; G8_MMA(1, 0, At, B0); G8_MMA(1, 1, At, B1); G8_BAR; G8_SCHED;
            } else {
            G8_LDB(B0, 0, 0); G8_SCHED; G8_LDA(At, 0, 0); G8_ST(G8_SA(1, 1), a1 + hA, voffA);
            G8_WL(8); G8_BAR; G8_WL(0); G8_MMA(0, 0, At, B0); G8_BAR; G8_SCHED;
            G8_LDB(B1, 0, 1); G8_ST(G8_SB(0, 0), b2, voffB);
            G8_BAR; G8_WL(0); G8_MMA(0, 1, At, B1); G8_BAR;
            G8_LDA(At, 0, 1); G8_ST(G8_SA(0, 0), a2, voffA);
            G8_BAR; G8_WL(0); G8_MMA(1, 0, At, B0); G8_BAR; G8_SCHED;
            G8_ST(G8_SB(0, 1), b2 + hB, voffB);
            G8_WV(6); G8_BAR; G8_MMA(1, 1, At, B1); G8_BAR;
            G8_LDB(B0, 1, 0); G8_SCHED; G8_LDA(At, 1, 0); G8_ST(G8_SA(0, 1), a2 + hA, voffA);
            G8_WL(8); G8_BAR; G8_WL(0); G8_MMA(0, 0, At, B0); G8_BAR; G8_SCHED;
            G8_LDB(B1, 1, 1); G8_ST(G8_SB(1, 0), b3, voffB);
            G8_BAR; G8_WL(0); G8_MMA(0, 1, At, B1); G8_BAR;
            G8_LDA(At, 1, 1); G8_ST(G8_SA(1, 0), a3, voffA);
            G8_BAR; G8_WL(0); G8_MMA(1, 0, At, B0); G8_BAR; G8_SCHED;
            G8_ST(G8_SB(1, 1), b3 + hB, voffB);
            G8_WV(6); G8_BAR; G8_MMA(1, 1, At, B1); G8_BAR;
            }
        }
        if constexpr (!AFTER_DRAIN) { if (wr == 0) G8_BAR; }
        if constexpr (!AFTER_DRAIN) epi.run(acc, brow + wr * 64 + fr, bcol + wc * 32 + fq * (Epi::PERM ? 8 : 4), wid, lane);
        if (!has_next) break;
#pragma unroll
        for (int a = 0; a < 2; ++a)
#pragma unroll
            for (int b = 0; b < 2; ++b)
#pragma unroll
                for (int m = 0; m < 4; ++m)
#pragma unroll
                    for (int n = 0; n < 2; ++n) acc[a][b][m][n] = (f32x4v){0.f, 0.f, 0.f, 0.f};
        brow = nbrow; bcol = nbcol; cA0 = nA; cA1 = (const char*)A1 + (size_t)nbrow * lda * 2; cB = nB; ++ui;
        if constexpr (!AFTER_DRAIN) { if (wr == 1) G8_BAR; }
    }
    G8_WV(0);
    if constexpr (AFTER_DRAIN) { if (wr == 0) G8_BAR; }
    G8_BAR;
    if constexpr (AFTER_DRAIN) epi.run(acc, brow + wr * 64 + fr, bcol + wc * 32 + fq * (Epi::PERM ? 8 : 4), wid, lane);
}
struct SchedProj { int bx, G, total;
    __device__ __forceinline__ bool get(int i, int& brow, int& bcol) const { const int t_ = bx + i * G; if (t_ >= total) return false; const int t = t_ % 576; const int grp = t / 36, w = t % 36;
        brow = (grp * 4 + (w & 3)) * 256; bcol = (w >> 2) * 256; return true; } };
struct SchedP1 { int bx, G, mode;
    __device__ __forceinline__ bool get(int i, int& brow, int& bcol) const {
        if (mode == 1) { if (i > 1) return false; const int t = bx + i * 256; const int grp = t >> 5, w = t & 31; brow = (grp * 4 + (w & 3)) * 256; bcol = (w >> 2) * 256; return true; }
        if (mode == 2) { if (i != 0 || bx >= 64) return false; brow = bx * 256; bcol = 8 * 256; return true; }
        const int t = bx + i * G; if (t >= 576) return false; const int grp = t / 36, w = t % 36; brow = (grp * 4 + (w & 3)) * 256; bcol = (w >> 2) * 256; return true; } };
struct SchedOut { int bx;
    __device__ __forceinline__ bool get(int i, int& brow, int& bcol) const { if (i != 0 || bx >= 256) return false; brow = (bx >> 2) * 256; bcol = (bx & 3) * 256; return true; } };

struct EpiProj8 {
    static constexpr bool PERM = true;
    bf16_t *Q, *Kk, *VT, *Za, *Ug, *Zs; const float* rope;
    __device__ __forceinline__ void run(const f32x4v (&acc)[2][2][4][2], int row0, int col0, int wid, int lane) const {
#pragma unroll
        for (int ai = 0; ai < 2; ++ai)
#pragma unroll
            for (int m = 0; m < 4; ++m) {
                const int row = row0 + ai * 128 + m * 16, t = row & 4095;
#pragma unroll
                for (int bj = 0; bj < 2; ++bj) {
                    const int col = col0 + bj * 128;
                    const int cb = col & ~63;
                    f32x4v v0 = acc[ai][bj][m][0], v1 = acc[ai][bj][m][1];
                    if (cb < 640) {
                        const int i0 = (col & 63) >> 1;
                        const f32x4 c0 = *(const f32x4*)(rope + ((size_t)t * 32 + i0) * 2), c1 = *(const f32x4*)(rope + ((size_t)t * 32 + i0 + 2) * 2);
                        float o0 = v0[0] * c0[0] - v0[1] * c0[1], o1 = v0[1] * c0[0] + v0[0] * c0[1], o2 = v0[2] * c0[2] - v0[3] * c0[3], o3 = v0[3] * c0[2] + v0[2] * c0[3];
                        float o4 = v1[0] * c1[0] - v1[1] * c1[1], o5 = v1[1] * c1[0] + v1[0] * c1[1], o6 = v1[2] * c1[2] - v1[3] * c1[3], o7 = v1[3] * c1[2] + v1[2] * c1[3];
                        if (cb < 512) { o0 *= QSCALE; o1 *= QSCALE; o2 *= QSCALE; o3 *= QSCALE; o4 *= QSCALE; o5 *= QSCALE; o6 *= QSCALE; o7 *= QSCALE; }
                        const u32x4 w = (u32x4){pk_bf16(o0, o1), pk_bf16(o2, o3), pk_bf16(o4, o5), pk_bf16(o6, o7)};
                        if (cb < 512) *(u32x4*)(Q + (size_t)row * 512 + col) = w; else *(u32x4*)(Kk + (size_t)row * 128 + (col - 512)) = w;
                    } else if (cb < 768) {
                        const int c = col - 640, b = row >> 12;
                        bf16_t* p = VT + ((size_t)(b * 128 + c)) * 4096 + t;
                        p[0] = to_bf16(v0[0]); p[4096] = to_bf16(v0[1]); p[8192] = to_bf16(v0[2]); p[12288] = to_bf16(v0[3]);
                        p[16384] = to_bf16(v1[0]); p[20480] = to_bf16(v1[1]); p[24576] = to_bf16(v1[2]); p[28672] = to_bf16(v1[3]);
                    } else {
                        const u32x4 w = (u32x4){pk_bf16(v0[0], v0[1]), pk_bf16(v0[2], v0[3]), pk_bf16(v1[0], v1[1]), pk_bf16(v1[2], v1[3])};
                        if (cb < 1280) *(u32x4*)(Za + (size_t)row * 512 + (col - 768)) = w;
                        else if (cb < 1792) { const int c = col - 1280; *(u32x4*)(Ug + ((size_t)(c >> 4) * 16384 + row) * 16 + (c & 15)) = w; }
                        else *(u32x4*)(Zs + (size_t)row * 512 + (col - 1792)) = w;
                    }
                }
            }
    }
};
struct EpiOut8 {
    static constexpr bool PERM = false;
    LAS unsigned char* lds; const float *x, *ssqA, *ssqS, *ln_g, *ln_b; float* out; unsigned long long* lnst; unsigned* cnt; unsigned target;
    __device__ __forceinline__ void pre(int brow, int tid) const {
        if (tid < 256) { const float ra = rstd8(ssqA + (size_t)(brow + tid) * 8), rs = rstd8(ssqS + (size_t)(brow + tid) * 8); *(LAS f32x2*)(lds + LDS8_TAB + tid * 8) = (f32x2){ra / rs, rs}; }
    }
    __device__ __forceinline__ void mid(f32x4v (&acc)[2][2][4][2], int lrow) const {
#pragma unroll
        for (int ai = 0; ai < 2; ++ai)
#pragma unroll
            for (int m = 0; m < 4; ++m) {
                const float f = (*(const LAS f32x2*)(lds + LDS8_TAB + (lrow + ai * 128 + m * 16) * 8)).x;
#pragma unroll
                for (int bj = 0; bj < 2; ++bj)
#pragma unroll
                    for (int n = 0; n < 2; ++n) acc[ai][bj][m][n] *= f;
            }
    }
    __device__ __forceinline__ void run(f32x4v (&acc)[2][2][4][2], int row0, int col0, int wid, int lane) const {
        const int fq = lane >> 4, wc = wid & 3, part = ((col0 - fq * 4) >> 8) * 4 + wc;
        f32x4 xv[2][4];
#pragma unroll
        for (int c = 0; c < 4; ++c) xv[0][c] = *(const f32x4*)(x + (size_t)row0 * 1024 + col0 + (c >> 1) * 128 + (c & 1) * 16);
#pragma unroll
        for (int g = 0; g < 8; ++g) {
            const int ai = g >> 2, m = g & 3, row = row0 + ai * 128 + m * 16;
            if (g < 7) { const int row1 = row0 + ((g + 1) >> 2) * 128 + ((g + 1) & 3) * 16;
#pragma unroll
                for (int c = 0; c < 4; ++c) xv[(g + 1) & 1][c] = *(const f32x4*)(x + (size_t)row1 * 1024 + col0 + (c >> 1) * 128 + (c & 1) * 16); }
            const float rs = (*(const LAS f32x2*)(lds + LDS8_TAB + ((row & 255)) * 8)).y;
            float sum = 0.f, sq = 0.f;
#pragma unroll
            for (int c = 0; c < 4; ++c) {
                const int bj = c >> 1, n = c & 1;
                f32x4v hv;
#pragma unroll
                for (int j = 0; j < 4; ++j) { hv[j] = DN_ALPHA * xv[g & 1][c][j] + acc[ai][bj][m][n][j] * rs; sum += hv[j]; sq += hv[j] * hv[j]; }
                acc[ai][bj][m][n] = hv;
            }
            sum += __shfl_xor(sum, 16); sq += __shfl_xor(sq, 16); sum += __shfl_xor(sum, 32); sq += __shfl_xor(sq, 32);
            if (fq == 0) __hip_atomic_store(lnst + (size_t)row * 16 + part, ((unsigned long long)__float_as_uint(sq) << 32) | __float_as_uint(sum), __ATOMIC_RELAXED, __HIP_MEMORY_SCOPE_AGENT);
        }
        asm volatile("s_waitcnt vmcnt(0)" ::: "memory");
        if (lane == 0) __hip_atomic_fetch_add(cnt, 1u, __ATOMIC_RELAXED, __HIP_MEMORY_SCOPE_AGENT);
        f32x4 gg[4], bb[4];
#pragma unroll
        for (int c = 0; c < 4; ++c) { const int col = col0 + (c >> 1) * 128 + (c & 1) * 16; gg[c] = *(const f32x4*)(ln_g + col); bb[c] = *(const f32x4*)(ln_b + col); }
        { unsigned sp = 0; while (__hip_atomic_load(cnt, __ATOMIC_RELAXED, __HIP_MEMORY_SCOPE_AGENT) < target) { __builtin_amdgcn_s_sleep(2); if (++sp > (1u << 24)) break; } }
        asm volatile("" ::: "memory");
#pragma unroll
        for (int ai = 0; ai < 2; ++ai) {
            unsigned long long w[4][4];
#pragma unroll
            for (int m = 0; m < 4; ++m)
#pragma unroll
                for (int t = 0; t < 4; ++t) w[m][t] = __hip_atomic_load(lnst + (size_t)(row0 + ai * 128 + m * 16) * 16 + fq * 4 + t, __ATOMIC_RELAXED, __HIP_MEMORY_SCOPE_AGENT);
#pragma unroll
            for (int m = 0; m < 4; ++m) {
                const int row = row0 + ai * 128 + m * 16;
                float sum = 0.f, sq = 0.f;
#pragma unroll
                for (int t = 0; t < 4; ++t) { sum += __uint_as_float((unsigned)w[m][t]); sq += __uint_as_float((unsigned)(w[m][t] >> 32)); }
                sum += __shfl_xor(sum, 16); sq += __shfl_xor(sq, 16); sum += __shfl_xor(sum, 32); sq += __shfl_xor(sq, 32);
                const float mean = sum * (1.0f / 1024.0f);
                const float var = fmaxf(sq * (1.0f / 1024.0f) - mean * mean, 0.f);
                const float rstd = 1.0f / sqrtf(var + NORM_EPS);
#pragma unroll
                for (int c = 0; c < 4; ++c) {
                    const int bj = c >> 1, n = c & 1, col = col0 + bj * 128 + n * 16;
                    f32x4 o;
#pragma unroll
                    for (int j = 0; j < 4; ++j) o[j] = (acc[ai][bj][m][n][j] - mean) * rstd * gg[c][j] + bb[c][j];
                    *(f32x4*)(out + (size_t)row * 1024 + col) = o;
                }
            }
        }
    }
};

struct SsmIn { const float *a_re, *a_im, *log_dt, *b_re, *b_im, *c_re, *c_im, *ssm_d; };
__device__ __forceinline__ void ssm_tables(LAS unsigned char* lds, const SsmIn P, float* lam_, bf16_t* Ws_, bf16_t* TW_, int g, int part) {
    int tid = threadIdx.x; asm volatile("" : "+v"(tid));
    LAS f32x2* pw = (LAS f32x2*)lds;
    LAS f32x2* Bb = (LAS f32x2*)(lds + 17408);
    LAS float* Kt = (LAS float*)(lds + 17408 + 16384);
    LAS f32x2* Cc = (LAS f32x2*)(lds + 17408 + 16384 + 32768);
    __syncthreads();
    {
        const int dir = (tid >> 6) & 1, p = tid & 63, dq = tid >> 7;
        const int gi = (dir * 32 + g) * 64 + p;
        const float dt = expf(P.log_dt[dir * 32 + g]);
        const float ar = P.a_re[gi], ai = P.a_im[gi];
        for (int d = dq; d <= 16; d += 4) {
            const float mg = expf((float)d * dt * ar); float sn, cn; sincosf((float)d * dt * ai, &sn, &cn);
            pw[(dir * 64 + p) * 17 + d] = (f32x2){mg * cn, mg * sn};
        }
        if (dq == 0) {
            const float mag = expf(dt * ar);
            const float lr = mag * cosf(dt * ai), li = mag * sinf(dt * ai);
            const float den = ar * ar + ai * ai;
            const float fr = ((lr - 1.0f) * ar + li * ai) / den, fi = (li * ar - (lr - 1.0f) * ai) / den;
            for (int ch = 0; ch < 16; ++ch) {
                const float br = P.b_re[(size_t)gi * 16 + ch], bi = P.b_im[(size_t)gi * 16 + ch];
                Bb[(dir * 64 + p) * 16 + ch] = (f32x2){fr * br - fi * bi, fr * bi + fi * br};
            }
        }
        if (dq == 1 && part == 0) {
            const double dar = (double)dt * (double)ar, dai = (double)dt * (double)ai;
            { const double mg = exp(dar * 16.0); double sn, cn; sincos(dai * 16.0, &sn, &cn);
              *(f32x2*)(lam_ + ((size_t)(g * 2 + dir) * 64 + p) * 2) = (f32x2){(float)(mg * cn), (float)(mg * sn)}; }
            { const double mg = exp(dar * 512.0); double sn, cn; sincos(dai * 512.0, &sn, &cn);
              *(f32x2*)(lam_ + 8192 + ((size_t)(g * 2 + dir) * 64 + p) * 2) = (f32x2){(float)(mg * cn), (float)(mg * sn)}; }
        }
        for (int i = tid; i < 2048; i += NT) { const int d2 = i >> 10, c = (i >> 6) & 15, pp = i & 63; const size_t ci = ((size_t)(d2 * 32 + g) * 16 + c) * 64 + pp; Cc[i] = (f32x2){P.c_re[ci], P.c_im[ci]}; }
    }
    __syncthreads();
    if (part == 0) for (int task = tid; task < 2048; task += NT) {
        const int dir = task >> 10, p = (task >> 4) & 63, j = task & 15;
        const int e = dir == 0 ? 15 - j : j;
        const f32x2 pwv = pw[(dir * 64 + p) * 17 + e];
        unsigned wr[8], wi[8];
#pragma unroll
        for (int c2 = 0; c2 < 8; ++c2) {
            const f32x2 b0 = Bb[(dir * 64 + p) * 16 + 2 * c2], b1 = Bb[(dir * 64 + p) * 16 + 2 * c2 + 1];
            wr[c2] = pk_bf16(pwv.x * b0.x - pwv.y * b0.y, pwv.x * b1.x - pwv.y * b1.y);
            wi[c2] = pk_bf16(pwv.x * b0.y + pwv.y * b0.x, pwv.x * b1.y + pwv.y * b1.x);
        }
        bf16_t* dst = Ws_ + ((size_t)g * 256 + dir * 128 + 2 * p) * 256 + j * 16;
        *(u32x4*)dst = (u32x4){wr[0], wr[1], wr[2], wr[3]}; *(u32x4*)(dst + 8) = (u32x4){wr[4], wr[5], wr[6], wr[7]};
        *(u32x4*)(dst + 256) = (u32x4){wi[0], wi[1], wi[2], wi[3]}; *(u32x4*)(dst + 256 + 8) = (u32x4){wi[4], wi[5], wi[6], wi[7]};
    }
    if (part == 1) for (int task = tid; task < 2048; task += NT) {
        const int dir = task >> 10, i = (task >> 6) & 15, p = task & 63;
        const int e = dir == 0 ? i + 1 : 16 - i;
        const f32x2 pwv = pw[(dir * 64 + p) * 17 + e];
#pragma unroll 4
        for (int c = 0; c < 16; ++c) {
            const f32x2 cc = Cc[(dir * 16 + c) * 64 + p];
            const float er = cc.x * pwv.x - cc.y * pwv.y, ei = cc.x * pwv.y + cc.y * pwv.x;
            *(unsigned*)(TW_ + ((size_t)g * 256 + i * 16 + c) * 512 + 256 + dir * 128 + 2 * p) = pk_bf16(er, -ei);
        }
    }
    if (part >= 2) {
        const int dir = tid >> 8, d = (tid >> 4) & 15, c = tid & 15;
        float a[16];
#pragma unroll
        for (int ch = 0; ch < 16; ++ch) a[ch] = 0.f;
        for (int p = 0; p < 64; ++p) {
            const f32x2 cc = Cc[(dir * 16 + c) * 64 + p];
            const f32x2 pwv = pw[(dir * 64 + p) * 17 + d];
            const float er = cc.x * pwv.x - cc.y * pwv.y, ei = cc.x * pwv.y + cc.y * pwv.x;
#pragma unroll
            for (int ch = 0; ch < 16; ++ch) { const f32x2 bb = Bb[(dir * 64 + p) * 16 + ch]; a[ch] += er * bb.x - ei * bb.y; }
        }
#pragma unroll
        for (int ch = 0; ch < 16; ++ch) Kt[((dir * 16 + d) * 16 + c) * 16 + ch] = a[ch];
    }
    __syncthreads();
    if (part >= 2) for (int task = (part - 2) * 4096 + tid; task < (part - 1) * 4096; task += NT) {
        const int n = task >> 5, kg = task & 31;
        const int i = n >> 4, c = n & 15, j = kg >> 1, ch0 = (kg & 1) * 8;
        float v[8];
#pragma unroll
        for (int e = 0; e < 8; ++e) {
            float sacc = 0.f;
            if (j <= i) sacc += Kt[((0 * 16 + (i - j)) * 16 + c) * 16 + ch0 + e];
            if (j >= i) sacc += Kt[((1 * 16 + (j - i)) * 16 + c) * 16 + ch0 + e];
            if (i == j && c == ch0 + e) sacc += P.ssm_d[g * 16 + c];
            v[e] = sacc;
        }
        *(u32x4*)(TW_ + ((size_t)g * 256 + n) * 512 + kg * 8) = (u32x4){pk_bf16(v[0], v[1]), pk_bf16(v[2], v[3]), pk_bf16(v[4], v[5]), pk_bf16(v[6], v[7])};
    }
    __syncthreads();
}

__device__ __forceinline__ void phase_prologue(LAS unsigned char* lds, const Args& args) {
    int tid = threadIdx.x; asm volatile("" : "+v"(tid));
    unsigned char* ws = args.ws;
    const size_t gtid = (size_t)blockIdx.x * NT + tid, gsz = (size_t)gridDim.x * NT;
    {
        const float* x = args.in[0]; bf16_t* Xb = (bf16_t*)(ws + WS_XB);
        for (size_t i = gtid; i < (size_t)MTOK * DM / 8; i += gsz) {
            const f32x4 a = *(const f32x4*)(x + i * 8), b = *(const f32x4*)(x + i * 8 + 4);
            *(u32x4*)(Xb + i * 8) = (u32x4){pk_bf16(a[0], a[1]), pk_bf16(a[2], a[3]), pk_bf16(b[0], b[1]), pk_bf16(b[2], b[3])};
        }
    }
    {
        const float* w_in = args.in[1]; bf16_t* WinT = (bf16_t*)(ws + WS_WINT);
        for (size_t i = gtid; i < (size_t)NPROJ * 128; i += gsz) {
            const int n = (int)(i % NPROJ), kg = (int)(i / NPROJ);
            int src = n;
            if (n < 640) { const int c = n & 63; src = (n & ~63) + ((c & 1) ? 32 + (c >> 1) : (c >> 1)); }
            float v[8];
#pragma unroll
            for (int j = 0; j < 8; ++j) v[j] = w_in[(size_t)(kg * 8 + j) * NPROJ + src];
            *(u32x4*)(WinT + (size_t)n * 1024 + kg * 8) = (u32x4){pk_bf16(v[0], v[1]), pk_bf16(v[2], v[3]), pk_bf16(v[4], v[5]), pk_bf16(v[6], v[7])};
        }
    }
    {
        float* rope = (float*)(ws + WS_ROPE);
        for (size_t i = gtid; i < (size_t)4096 * 32; i += gsz) {
            const int t = (int)(i >> 5), k = (int)(i & 31);
            const float inv_freq = powf(10000.0f, -(float)k / 32.0f);
            const float ang = (float)t * inv_freq;
            double sn, cn; sincos((double)ang, &sn, &cn);
            *(f32x2*)(rope + i * 2) = (f32x2){(float)cn, (float)sn};
        }
    }
}

__device__ __forceinline__ void phase_prologue_b(LAS unsigned char* lds, const Args& args, int sb, int nsb) {
    int tid = threadIdx.x; asm volatile("" : "+v"(tid));
    unsigned char* ws = args.ws;
    const size_t gtid = (size_t)sb * NT + tid, gsz = (size_t)nsb * NT;
    {
        const SsmIn SI{args.in[3], args.in[4], args.in[5], args.in[6], args.in[7], args.in[8], args.in[9], args.in[10]};
        for (int u = sb; u < 128; u += nsb) ssm_tables(lds, SI, (float*)(ws + WS_LAM), (bf16_t*)(ws + WS_WS), (bf16_t*)(ws + WS_TW), u >> 2, u & 3);
    }
    {
        const float* w_glu = args.in[11]; bf16_t* WgluT = (bf16_t*)(ws + WS_WGLUT);
        for (size_t i = gtid; i < (size_t)512 * 64; i += gsz) {
            const int n = (int)(i & 511), kg = (int)(i >> 9);
            float v[8];
#pragma unroll
            for (int j = 0; j < 8; ++j) v[j] = w_glu[(size_t)(kg * 8 + j) * 512 + n];
            *(u32x4*)(WgluT + (size_t)n * 512 + kg * 8) = (u32x4){pk_bf16(v[0], v[1]), pk_bf16(v[2], v[3]), pk_bf16(v[4], v[5]), pk_bf16(v[6], v[7])};
        }
    }
    {
        const float* w_out = args.in[15]; const float* g_attn = args.in[13]; const float* g_ssm = args.in[14]; bf16_t* WoutT = (bf16_t*)(ws + WS_WOUTT);
        for (size_t i = gtid; i < (size_t)1024 * 128; i += gsz) {
            const int n = (int)(i & 1023), kg = (int)(i >> 10);
            float v[8];
#pragma unroll
            for (int j = 0; j < 8; ++j) { const int k = kg * 8 + j; const float gn = k < 512 ? g_attn[k] : g_ssm[k - 512]; v[j] = w_out[(size_t)k * 1024 + n] * gn; }
            *(u32x4*)(WoutT + (size_t)n * 1024 + kg * 8) = (u32x4){pk_bf16(v[0], v[1]), pk_bf16(v[2], v[3]), pk_bf16(v[4], v[5]), pk_bf16(v[6], v[7])};
        }
    }
}

constexpr int VROWB = 136;
struct AttnP { const bf16_t *Q, *Kk, *VT, *Za; const float* sink; bf16_t* Ya; float* ssqA; };
__device__ __forceinline__ void attn_item(LAS unsigned char* lds, const AttnP P, int it) {
    int tid = threadIdx.x; asm volatile("" : "+v"(tid));
    const int lane = tid & 63, hd = __builtin_amdgcn_readfirstlane(tid >> 6), kvh = hd >> 2, r32 = lane & 31, h = lane >> 5;
    const int b = it >> 6, q0 = (it & 63) * 64;
    const size_t row0 = (size_t)b * 4096 + q0;
    bf16x8 qf[2][4];
#pragma unroll
    for (int nq = 0; nq < 2; ++nq)
#pragma unroll
        for (int s = 0; s < 4; ++s) qf[nq][s] = *(const bf16x8*)(P.Q + (row0 + nq * 32 + r32) * 512 + hd * 64 + s * 16 + h * 8);
    const float sink2 = P.sink[hd] * LOG2E;
    float mrun[2] = {sink2, sink2}, lrun[2] = {1.f, 1.f};
    f32x16 O[2][2];
#pragma unroll
    for (int i = 0; i < 2; ++i)
#pragma unroll
        for (int j = 0; j < 2; ++j)
#pragma unroll
            for (int r = 0; r < 16; ++r) O[i][j][r] = 0.f;
    LAS unsigned char* Ks = lds;
    LAS unsigned char* Vs = lds + 2 * 64 * ROWB;
    const int kb_lo = (q0 >= 128) ? -2 : -(q0 >> 6), kb_hi = (q0 + 128 <= 4032) ? 2 : ((4032 - q0) >> 6);
    u32x4 pk[2], pv[2];
#define AT_LOAD(kb_) do { const int _ks = q0 + (kb_) * 64; \
        _Pragma("unroll") for (int i = 0; i < 2; ++i) { const int c = tid + i * NT; \
            pk[i] = *(const u32x4*)(P.Kk + ((size_t)b * 4096 + _ks + (c >> 4)) * 128 + (c & 15) * 8); \
            pv[i] = *(const u32x4*)(P.VT + ((size_t)(b * 128 + (c >> 3))) * 4096 + _ks + (c & 7) * 8); } } while (0)
    AT_LOAD(kb_lo);
    for (int kb = kb_lo; kb <= kb_hi; ++kb) {
        __syncthreads();
#pragma unroll
        for (int i = 0; i < 2; ++i) {
            const int c = tid + i * NT, key = c >> 4, part = c & 15;
            *(LAS u32x4*)(Ks + ((part >> 3) * 64 + key) * ROWB + (part & 7) * 16) = pk[i];
            const int rowv = c >> 3, c8 = c & 7;
            *(LAS u32x2*)(Vs + rowv * VROWB + c8 * 16) = (u32x2){pv[i].x, pv[i].y};
            *(LAS u32x2*)(Vs + rowv * VROWB + c8 * 16 + 8) = (u32x2){pv[i].z, pv[i].w};
        }
        __syncthreads();
        if (kb < kb_hi) AT_LOAD(kb + 1);
#pragma unroll
        for (int nq = 0; nq < 2; ++nq) {
            f32x16 S[2];
#pragma unroll
            for (int r = 0; r < 16; ++r) { S[0][r] = 0.f; S[1][r] = 0.f; }
#pragma unroll
            for (int s = 0; s < 4; ++s) {
                const bf16x8 k0 = *(const LAS bf16x8*)(Ks + (kvh * 64 + r32) * ROWB + s * 32 + h * 16);
                const bf16x8 k1 = *(const LAS bf16x8*)(Ks + (kvh * 64 + 32 + r32) * ROWB + s * 32 + h * 16);
                S[0] = MFMA32(k0, qf[nq][s], S[0]);
                S[1] = MFMA32(k1, qf[nq][s], S[1]);
            }
            if (kb == -2 || kb == 2) {
                int base = nq * 32 + r32 - 4 * h;
                asm volatile("" : "+v"(base));
#pragma unroll
                for (int kg = 0; kg < 2; ++kg)
#pragma unroll
                    for (int r = 0; r < 16; ++r) {
                        const int kk = kg * 32 + (r & 3) + 8 * (r >> 2);
                        const bool ok = (kb == -2) ? (kk >= base) : (kk <= base);
                        S[kg][r] = ok ? S[kg][r] : -1e30f;
                    }
            }
            float mx = S[0][0];
#pragma unroll
            for (int r = 1; r < 16; ++r) mx = fmaxf(mx, S[0][r]);
#pragma unroll
            for (int r = 0; r < 16; ++r) mx = fmaxf(mx, S[1][r]);
            mx = fmaxf(mx, __shfl_xor(mx, 32));
            const float mnew = fmaxf(mrun[nq], mx);
            const float alpha = fast_exp2(mrun[nq] - mnew);
            float rs = 0.f;
#pragma unroll
            for (int kg = 0; kg < 2; ++kg)
#pragma unroll
                for (int r = 0; r < 16; ++r) { const float p = fast_exp2(S[kg][r] - mnew); S[kg][r] = p; rs += p; }
            rs += __shfl_xor(rs, 32);
            lrun[nq] = lrun[nq] * alpha + rs; mrun[nq] = mnew;
#pragma unroll
            for (int dg = 0; dg < 2; ++dg)
#pragma unroll
                for (int r = 0; r < 16; ++r) O[dg][nq][r] *= alpha;
#pragma unroll
            for (int kg = 0; kg < 2; ++kg)
#pragma unroll
                for (int s2 = 0; s2 < 2; ++s2) {
                    const u32x4 w = (u32x4){pk_bf16(S[kg][8 * s2], S[kg][8 * s2 + 1]), pk_bf16(S[kg][8 * s2 + 2], S[kg][8 * s2 + 3]),
                                            pk_bf16(S[kg][8 * s2 + 4], S[kg][8 * s2 + 5]), pk_bf16(S[kg][8 * s2 + 6], S[kg][8 * s2 + 7])};
                    const bf16x8 pf = __builtin_bit_cast(bf16x8, w);
#pragma unroll
                    for (int dg = 0; dg < 2; ++dg) {
                        const LAS unsigned char* vb = Vs + (kvh * 64 + dg * 32 + r32) * VROWB + (kg * 32 + s2 * 16 + 4 * h) * 2;
                        const u32x2 lo = *(const LAS u32x2*)vb, hi = *(const LAS u32x2*)(vb + 16);
                        const bf16x8 vf = __builtin_bit_cast(bf16x8, ((u32x4){lo.x, lo.y, hi.x, hi.y}));
                        O[dg][nq] = MFMA32(vf, pf, O[dg][nq]);
                    }
                }
        }
    }
#pragma unroll
    for (int nq = 0; nq < 2; ++nq) {
        const size_t row = row0 + nq * 32 + r32;
        const float inv = 1.0f / lrun[nq];
        float ssq = 0.f;
#pragma unroll
        for (int dg = 0; dg < 2; ++dg)
#pragma unroll
            for (int q = 0; q < 4; ++q) {
                const int d = hd * 64 + dg * 32 + q * 8 + h * 4;
                const u32x2 zw = *(const u32x2*)(P.Za + row * 512 + d);
                const float y0 = O[dg][nq][4 * q] * inv * siluf_(bf_lo(zw.x)), y1 = O[dg][nq][4 * q + 1] * inv * siluf_(bf_hi(zw.x));
                const float y2 = O[dg][nq][4 * q + 2] * inv * siluf_(bf_lo(zw.y)), y3 = O[dg][nq][4 * q + 3] * inv * siluf_(bf_hi(zw.y));
                ssq += (y0 * y0 + y1 * y1) + (y2 * y2 + y3 * y3);
                u32x2 w; w.x = pk_bf16(y0, y1); w.y = pk_bf16(y2, y3);
                *(u32x2*)(P.Ya + row * 512 + d) = w;
            }
        ssq += __shfl_xor(ssq, 32);
        if (h == 0) P.ssqA[row * 8 + hd] = ssq;
    }
}

#ifndef G8_SP2
#define G8_SP2 true
#endif
constexpr int NPHASE = 6;
#ifndef REP0
#define REP0 1
#endif
#ifndef REP1
#define REP1 1
#endif
#ifndef REP2
#define REP2 1
#endif
#ifndef REP3
#define REP3 1
#endif
#ifndef REP4
#define REP4 1
#endif
#ifndef REP5
#define REP5 1
#endif
#ifndef REP6
#define REP6 1
#endif
__global__ void __launch_bounds__(NT) fwd_kernel(Args args) {
    extern __shared__ __attribute__((aligned(16))) unsigned char lds_raw[];
    LAS unsigned char* lds = (LAS unsigned char*)lds_raw;
    const int tid = threadIdx.x;
    unsigned char* ws = args.ws;
    volatile LAS unsigned* st = (volatile LAS unsigned*)(lds + LDS_MAIN2);
    if (tid < 16) st[tid] = 0u;
    __syncthreads();
    const int lo = args.ph_lo, hi = args.ph_hi;
    XcdBarrier bar; bar.bar = (unsigned*)(ws + WS_BAR); bar.x = 0; bar.st = st;
    if (hi - lo > 1) bar = xcd_barrier_post((unsigned*)(ws + WS_BAR), st);
    if (args.never) cg::this_grid().sync();
#ifndef ONLY
#define ONLY -1
#endif
#ifndef PHMASK
#define PHMASK 255
#endif
#define IN(k) (((PHMASK >> (k)) & 1) && (ONLY < 0 || ONLY == (k)) && lo <= (k) && (k) < hi)
#define SEAM(k) do { if (IN(k) && IN((k) + 1)) xcd_barrier(bar); } while (0)
    const int G = gridDim.x, bx = (gridDim.x % 8 == 0) ? (int)((blockIdx.x % 8) * (gridDim.x / 8) + blockIdx.x / 8) : (int)blockIdx.x;

    if (IN(0)) for (int rep = 0; rep < REP0; ++rep) phase_prologue(lds, args);
    SEAM(0);
    const bool fast = false;
    unsigned* evt = (unsigned*)(ws + WS_BAR) + 64;
    if (IN(1)) {
        const bf16_t* Xb = (const bf16_t*)(ws + WS_XB); const bf16_t* WinT = (const bf16_t*)(ws + WS_WINT);
        EpiProj8 E8{(bf16_t*)(ws + WS_Q), (bf16_t*)(ws + WS_K), (bf16_t*)(ws + WS_VT), (bf16_t*)(ws + WS_ZA), (bf16_t*)(ws + WS_UG), (bf16_t*)(ws + WS_ZS), (const float*)(ws + WS_ROPE)};
#pragma clang loop unroll(disable)
        for (int stage = 0; stage < (fast ? 2 : 1); ++stage) {
            const SchedP1 SP{bx, G, fast ? stage + 1 : 0};
            gemm8_phase<EpiProj8, SchedP1, false, false, G8_SP2>(lds, Xb, Xb, 1024, 1 << 20, WinT, 1024, 16, SP, E8);
            if (stage == 0) {
                if (fast) { if (bx >= 64) phase_prologue_b(lds, args, bx - 64, 192); }
                else { int ntile = 0; for (int t_ = bx; t_ < 576; t_ += G) ++ntile; const int nr = (576 + G - 1) / G;
                    if (ntile < nr || G >= 576) { int nshort = nr * G - 576, first = G - nshort; if (nshort <= 0 || nshort > G) { nshort = G; first = 0; } if (bx >= first) phase_prologue_b(lds, args, bx - first, nshort); } }
                if (fast) {
                    asm volatile("s_waitcnt vmcnt(0)" ::: "memory");
                    __syncthreads();
                    if (tid == 0) { __builtin_amdgcn_fence(__ATOMIC_RELEASE, "agent"); asm volatile("s_waitcnt vmcnt(0)" ::: "memory"); (void)xb_add(evt, 1u); }
                }
            }
        }
    }
    if (fast) {
        if (tid == 0) { XB_SPIN(xb_ld(evt) < 256u, (unsigned*)(ws + WS_BAR)); __builtin_amdgcn_fence(__ATOMIC_ACQUIRE, "agent"); asm volatile("s_waitcnt vmcnt(0)" ::: "memory"); }
        __syncthreads();
    } else SEAM(1);
    if (IN(2)) {
        const AttnP AP{(const bf16_t*)(ws + WS_Q), (const bf16_t*)(ws + WS_K), (const bf16_t*)(ws + WS_VT), (const bf16_t*)(ws + WS_ZA), args.in[2], (bf16_t*)(ws + WS_YA), (float*)(ws + WS_SSQA)};
        int a0 = bx, as_ = G, an = (256 - bx + G - 1) / G, t0 = bx, ts = G, tn = (256 - bx + G - 1) / G;
        if (bx >= 256) { an = 0; tn = 0; }
        if (fast) { const int wi = bx - 64; a0 = wi; as_ = 192; an = wi < 0 ? 0 : (wi < 64 ? 2 : 1); t0 = 2 * (wi - 64); ts = 1; tn = wi >= 64 ? 2 : 0; }
#pragma clang loop unroll(disable)
        for (int k = 0; k < an; ++k) attn_item(lds, AP, a0 + k * as_);
        __syncthreads();
#pragma clang loop unroll(disable)
        for (int k = 0; k < tn; ++k) { const int t = t0 + k * ts; const int g = t >> 3, mt = (t >> 1) & 3, nt_ = t & 1;
            EpiSScan E{lds, (const float*)(ws + WS_LAM), (bf16_t*)(ws + WS_XIN), g, mt, nt_};
            const bf16_t* A = (const bf16_t*)(ws + WS_UG) + (size_t)g * 16384 * 16;
            gemm_tile<EpiSScan, false>(lds, A, 256, A, 256, 1 << 30, (const bf16_t*)(ws + WS_WS) + (size_t)g * 256 * 256, 256, 256, mt * BM, nt_ * BN, E); }
    }
    SEAM(2);
    if (IN(3)) {
        for (int t_ = bx; t_ < 256 * REP4; t_ += G) { const int t = t_ & 255; const int g = t >> 3, mt = (t >> 1) & 3, nt_ = t & 1;
            EpiY E{(bf16_t*)(ws + WS_G), g};
            gemm_tile<EpiY, false>(lds, (const bf16_t*)(ws + WS_UG) + (size_t)g * 16384 * 16, 256, (const bf16_t*)(ws + WS_XIN) + (size_t)g * 1024 * 256, 256, 256, (const bf16_t*)(ws + WS_TW) + (size_t)g * 256 * 512, 512, 512, mt * BM, nt_ * BN, E); }
    }
    SEAM(3);
    if (IN(4)) {
        EpiGlu E{(const bf16_t*)(ws + WS_G), (const bf16_t*)(ws + WS_ZS), args.in[12], (bf16_t*)(ws + WS_YS), (float*)(ws + WS_SSQS)};
        const bf16_t* Gp = (const bf16_t*)(ws + WS_G); const bf16_t* WgluT = (const bf16_t*)(ws + WS_WGLUT);
        for (int t_ = bx; t_ < 64 * 4 * REP5; t_ += G) { const int t = t_ & 255; const int mt = t >> 2, nt_ = t & 3;
            gemm_tile<EpiGlu, false>(lds, Gp, 512, Gp, 512, 1 << 30, WgluT, 512, 512, mt * BM, nt_ * BN, E); }
    }
    SEAM(4);
    if (IN(5)) {
        const bf16_t* Ya = (const bf16_t*)(ws + WS_YA); const bf16_t* Ys = (const bf16_t*)(ws + WS_YS); const bf16_t* WoutT = (const bf16_t*)(ws + WS_WOUTT);
        if (bx < 256) { const int mt = bx >> 2;
            EpiOut8 E{lds, args.in[0], (const float*)(ws + WS_SSQA), (const float*)(ws + WS_SSQS), args.in[16], args.in[17], args.out, (unsigned long long*)(ws + WS_LNST),
                      (unsigned*)(ws + WS_CNT) + mt * 64, 32u};
            const SchedOut SO{bx};
            gemm8_phase<EpiOut8, SchedOut, true, true, G8_SP2>(lds, Ya, Ys, 512, 8, WoutT, 1024, 16, SO, E); }
    }
#undef IN
#undef SEAM
}

extern "C" void kernel_launch(void* const* d_in, const int* in_sizes, int n_in, void* d_out, int out_size, void* d_ws, size_t ws_size, hipStream_t stream) {
    static int grid = 0;
    if (grid == 0) {
        if (n_in != 18 || ws_size < WS_END) { fprintf(stderr, "kernel_launch: unexpected inputs (n_in %d, ws %zu, need %zu)\n", n_in, ws_size, (size_t)WS_END); grid = -1; return; }
        int dev = 0, cus = 0, per_cu = 0;
        hipGetDevice(&dev);
        hipDeviceGetAttribute(&cus, hipDeviceAttributeMultiprocessorCount, dev);
        if (hipFuncSetAttribute((const void*)fwd_kernel, hipFuncAttributeMaxDynamicSharedMemorySize, LDS_BYTES) != hipSuccess) { fprintf(stderr, "kernel_launch: hipFuncSetAttribute failed\n"); grid = -1; return; }
        if (hipOccupancyMaxActiveBlocksPerMultiprocessor(&per_cu, (const void*)fwd_kernel, NT, LDS_BYTES) != hipSuccess || per_cu < 1) { fprintf(stderr, "kernel_launch: occupancy query says %d\n", per_cu); per_cu = 1; }
        (void)hipGetLastError();
        grid = cus;
    }
    if (grid < 0) return;
    (void)hipMemsetAsync((char*)d_ws + WS_BAR, 0, 32768, stream);
    Args a{};
    for (int i = 0; i < 18; ++i) a.in[i] = (const float*)d_in[i];
    a.out = (float*)d_out; a.ws = (unsigned char*)d_ws; a.never = 0; a.pad = 0;
#if N_LAUNCH_MODE == 1
    for (int ph = 0; ph < NPHASE; ++ph) {
        a.ph_lo = ph; a.ph_hi = ph + 1;
        hipLaunchKernelGGL(fwd_kernel, dim3(grid), dim3(NT), LDS_BYTES, stream, a);
    }
#else
    a.ph_lo = 0; a.ph_hi = NPHASE;
    void* kargs[] = {&a};
    hipError_t e = hipLaunchCooperativeKernel((const void*)fwd_kernel, dim3(grid), dim3(NT), kargs, LDS_BYTES, stream);
    if (e != hipSuccess) fprintf(stderr, "kernel_launch: cooperative launch failed: %s (grid %d)\n", hipGetErrorString(e), grid);
#endif
}
```

```cpp
#include <hip/hip_runtime.h>
#include <hip/hip_cooperative_groups.h>
#include <cstdint>
#include <cstdio>
namespace cg = cooperative_groups;

#ifndef N_LAUNCH_MODE
#define N_LAUNCH_MODE 0
#endif

typedef unsigned short bf16_t;
typedef short bf16x8 __attribute__((ext_vector_type(8)));
typedef float f32x16 __attribute__((ext_vector_type(16)));
typedef float f32x4 __attribute__((ext_vector_type(4)));
typedef float f32x2 __attribute__((ext_vector_type(2)));
typedef unsigned u32x4 __attribute__((ext_vector_type(4)));
typedef unsigned u32x2 __attribute__((ext_vector_type(2)));
#define LAS __attribute__((address_space(3)))

constexpr int NT = 512;
constexpr int SEQ = 4096, DM = 1024, MTOK = 16384, NPROJ = 2304;
constexpr float LOG2E = 1.4426950408889634f;
constexpr float QSCALE = 0.125f * LOG2E;
constexpr float NORM_EPS = 1e-5f;
constexpr float DN_ALPHA = 1.189207115002721f;

constexpr size_t WS_BAR = 0;
constexpr size_t WS_CNT = 16384;
constexpr size_t WS_WINT = 32768;
constexpr size_t WS_WGLUT = WS_WINT + (size_t)2304 * 1024 * 2;
constexpr size_t WS_WOUTT = WS_WGLUT + (size_t)512 * 512 * 2;
constexpr size_t WS_ROPE = WS_WOUTT + (size_t)1024 * 1024 * 2;
constexpr size_t WS_LAM = WS_ROPE + (size_t)4096 * 32 * 8;
constexpr size_t WS_WS = WS_LAM + 65536;
constexpr size_t WS_TW = WS_WS + (size_t)32 * 256 * 256 * 2;
constexpr size_t WS_XB = WS_TW + (size_t)32 * 256 * 512 * 2;
constexpr size_t WS_S = WS_XB;
constexpr size_t WS_Q = WS_XB + (size_t)16384 * 1024 * 2;
constexpr size_t WS_K = WS_Q + (size_t)16384 * 512 * 2;
constexpr size_t WS_VT = WS_K + (size_t)16384 * 128 * 2;
constexpr size_t WS_ZA = WS_VT + (size_t)16384 * 128 * 2;
constexpr size_t WS_UG = WS_ZA + (size_t)16384 * 512 * 2;
constexpr size_t WS_ZS = WS_UG + (size_t)16384 * 512 * 2;
constexpr size_t WS_XIN = WS_ZS + (size_t)16384 * 512 * 2;
constexpr size_t WS_G = WS_XIN + (size_t)32 * 1024 * 256 * 2;
constexpr size_t WS_YA = WS_G + (size_t)16384 * 512 * 2;
constexpr size_t WS_YS = WS_YA + (size_t)16384 * 512 * 2;
constexpr size_t WS_SSQA = WS_YS + (size_t)16384 * 512 * 2;
constexpr size_t WS_SSQS = WS_SSQA + (size_t)16384 * 8 * 4;
constexpr size_t WS_LNST = WS_SSQS + (size_t)16384 * 8 * 4;
constexpr size_t WS_END = WS_LNST + (size_t)16384 * 16 * 2 * 4;

__device__ __forceinline__ unsigned pk_bf16(float lo, float hi) { unsigned r; asm("v_cvt_pk_bf16_f32 %0, %1, %2" : "=v"(r) : "v"(lo), "v"(hi)); return r; }
__device__ __forceinline__ bf16_t to_bf16(float v) { return (bf16_t)(pk_bf16(v, 0.f) & 0xffffu); }
__device__ __forceinline__ float bf_lo(unsigned w) { return __uint_as_float(w << 16); }
__device__ __forceinline__ float bf_hi(unsigned w) { return __uint_as_float(w & 0xffff0000u); }
__device__ __forceinline__ float fast_exp2(float x) { return __builtin_amdgcn_exp2f(x); }
__device__ __forceinline__ float sigmoidf_(float x) { return __builtin_amdgcn_rcpf(1.0f + __builtin_amdgcn_exp2f(-1.4426950408889634f * x)); }
__device__ __forceinline__ float siluf_(float x) { return x * sigmoidf_(x); }
__device__ __forceinline__ float gelu_tanh(float x) {
    const float z2 = 1.5957691216057308f * (x + 0.044715f * x * x * x);
    return x * __builtin_amdgcn_rcpf(1.0f + __builtin_amdgcn_exp2f(-1.4426950408889634f * z2));
}
#define MFMA32(a, b, c) __builtin_amdgcn_mfma_f32_32x32x16_bf16((a), (b), (c), 0, 0, 0)

#define XB_TMO      128
#define XB_XCNT(j)  (256  + 64 * (j))
#define XB_XSUB(j)  (1280 + 64 * (j))
#define XB_XGEN(j)  (2304 + 64 * (j))
#define XB_TOP      3328
#define XB_TOPGEN   3392
#define XCD_BAR_WORDS 3456
#define XB_SPIN_CAP (1u << 22)
__device__ __forceinline__ unsigned xb_ld(unsigned* p)              { return __hip_atomic_load(p, __ATOMIC_RELAXED, __HIP_MEMORY_SCOPE_AGENT); }
__device__ __forceinline__ unsigned xb_add(unsigned* p, unsigned v) { return __hip_atomic_fetch_add(p, v, __ATOMIC_RELAXED, __HIP_MEMORY_SCOPE_AGENT); }
__device__ __forceinline__ unsigned xb_xcc_id() { return (unsigned)__builtin_amdgcn_s_getreg((3 << 11) | 20) & 0xFu; }
#define XB_SPIN(cond, bar) do { unsigned _sp = 0; while (cond) { __builtin_amdgcn_s_sleep(1); \
    if ((++_sp & 255u) == 0u) { if (xb_ld(&(bar)[XB_TMO])) break; if (_sp > XB_SPIN_CAP) { atomicAdd(&(bar)[XB_TMO], 1u); break; } } } } while (0)
struct XcdBarrier { unsigned* bar; unsigned x; volatile LAS unsigned* st; };
__device__ __forceinline__ XcdBarrier xcd_barrier_post(unsigned* bar, volatile LAS unsigned* st) {
    XcdBarrier b; b.bar = bar; b.x = xb_xcc_id(); b.st = st;
    if (threadIdx.x == 0) (void)xb_add(&bar[XB_XCNT(b.x)], 1u);
    return b;
}
__device__ __forceinline__ void xcd_barrier_complete(unsigned* bar, unsigned x, unsigned& nloc, unsigned& nx) {
    const unsigned G = gridDim.x * gridDim.y * gridDim.z;
    unsigned sum, cnt, mine, sp = 0u;
    for (;;) {
        sum = 0u; cnt = 0u; mine = 0u;
#pragma unroll
        for (unsigned j = 0; j < 16; ++j) { const unsigned c = xb_ld(&bar[XB_XCNT(j)]); sum += c; cnt += (c > 0u) ? 1u : 0u; mine = (j == x) ? c : mine; }
        if (sum == G) break;
        __builtin_amdgcn_s_sleep(1);
        if ((++sp & 255u) == 0u) { if (xb_ld(&bar[XB_TMO])) break; if (sp > XB_SPIN_CAP) { atomicAdd(&bar[XB_TMO], 1u); break; } }
    }
    nloc = mine > 0u ? mine : 1u; nx = cnt > 0u ? cnt : 1u;
}
__device__ __forceinline__ void xcd_barrier(const XcdBarrier& b) {
    asm volatile("s_waitcnt vmcnt(0)" ::: "memory");
    __syncthreads();
    if (threadIdx.x == 0) {
        unsigned* bar = b.bar;
        __builtin_amdgcn_s_waitcnt(0);
        unsigned nloc = b.st[0], nx = b.st[1];
        if (nloc == 0u) { xcd_barrier_complete(bar, b.x, nloc, nx); b.st[0] = nloc; b.st[1] = nx; }
        const unsigned old = xb_add(&bar[XB_XSUB(b.x)], 1u);
        const unsigned gen = old / nloc;
        if (old + 1u == (gen + 1u) * nloc) {
            __builtin_amdgcn_fence(__ATOMIC_RELEASE, "agent");
            asm volatile("s_waitcnt vmcnt(0)" ::: "memory");
            const unsigned og = xb_add(&bar[XB_TOP], 1u);
            const unsigned tg = og / nx;
            if (og + 1u == (tg + 1u) * nx) xb_add(&bar[XB_TOPGEN], 1u);
            else XB_SPIN(xb_ld(&bar[XB_TOPGEN]) == tg, bar);
            __builtin_amdgcn_fence(__ATOMIC_ACQUIRE, "agent");
            xb_add(&bar[XB_XGEN(b.x)], 1u);
            asm volatile("s_waitcnt vmcnt(0)" ::: "memory");
        } else {
            XB_SPIN(xb_ld(&bar[XB_XGEN(b.x)]) == gen, bar);
            __builtin_amdgcn_fence(__ATOMIC_ACQUIRE, "agent");
            asm volatile("s_waitcnt vmcnt(0)" ::: "memory");
        }
    }
    __syncthreads();
}

struct Args { const float* in[18]; float* out; unsigned char* ws; int ph_lo, ph_hi, never, pad; };

constexpr int BM = 256, BN = 128, BK = 64;
constexpr int ROWB = 144;
constexpr int A_STAGE = BM * 128, B_STAGE = BN * 128, STAGE = A_STAGE + B_STAGE;
constexpr int LDS_MAIN = 3 * STAGE;
constexpr int SLDS_ROW = 528;
constexpr int LDS_SCAN_E = 256 * SLDS_ROW;
constexpr int LDS_MAIN2 = LDS_MAIN > (LDS_SCAN_E + 4096) ? LDS_MAIN : (LDS_SCAN_E + 4096);
constexpr int LDS_BYTES = LDS_MAIN2 + 64;

template <class Epi, bool MID>
__device__ __forceinline__ void gemm_tile(LAS unsigned char* lds, const bf16_t* __restrict__ A0, int lda0, const bf16_t* __restrict__ A1, int lda1, int ksplit,
                                          const bf16_t* __restrict__ Bt, int ldb, int K, int m0, int n0, const Epi& epi) {
    int tid = threadIdx.x; asm volatile("" : "+v"(tid));
    const int lane = tid & 63, wid = __builtin_amdgcn_readfirstlane(tid >> 6);
    const int wm = wid >> 1, wn = wid & 1, r32 = lane & 31, h = lane >> 5;
    const int grow = lane >> 3, gc = lane & 7;
    const int csrc = (gc ^ (((wid * 8 + grow) >> 1) & 7)) * 8;
    const int rs_ = (wid * 8 + grow) & 31, rperm = 16 * ((rs_ >> 2) & 1) + 4 * (rs_ >> 3) + (rs_ & 3);
    const size_t arow = (size_t)(m0 + wid * 8 + grow), brow = (size_t)(n0 + ((wid * 8 + grow) & ~31) + rperm);
    f32x16 acc[2][2];
#pragma unroll
    for (int i = 0; i < 2; ++i)
#pragma unroll
        for (int j = 0; j < 2; ++j)
#pragma unroll
            for (int r = 0; r < 16; ++r) acc[i][j][r] = 0.f;
    const int nt = K / BK;
#define GT_STAGE(kt, buf) do { const int _k0 = (kt) * BK; const bf16_t* _ab; int _ld, _kk; \
        if (_k0 < ksplit) { _ab = A0; _ld = lda0; _kk = _k0; } else { _ab = A1; _ld = lda1; _kk = _k0 - ksplit; } \
        const bf16_t* _ga = _ab + arow * _ld + _kk + csrc; const bf16_t* _gb = Bt + brow * ldb + _k0 + csrc; \
        LAS unsigned char* _la = lds + (buf) * STAGE + wid * 1024; \
        _Pragma("unroll") for (int _i = 0; _i < 4; ++_i) __builtin_amdgcn_global_load_lds((const unsigned*)(_ga + (size_t)_i * 64 * _ld), (LAS unsigned*)(_la + _i * 8192), 16, 0, 0); \
        _Pragma("unroll") for (int _i = 0; _i < 2; ++_i) __builtin_amdgcn_global_load_lds((const unsigned*)(_gb + (size_t)_i * 64 * ldb), (LAS unsigned*)(_la + A_STAGE + _i * 8192), 16, 0, 0); } while (0)
    const int swz = (r32 >> 1) & 7;
    const int o0 = ((0 + h) ^ swz) << 4, o1 = ((2 + h) ^ swz) << 4, o2 = ((4 + h) ^ swz) << 4, o3 = ((6 + h) ^ swz) << 4;
    int bcur = 0, bnxt = STAGE, bnn = 2 * STAGE;
    GT_STAGE(0, 0);
    if (nt > 1) GT_STAGE(1, 1);
    for (int kt = 0; kt < nt; ++kt) {
        if (kt + 1 < nt) asm volatile("s_waitcnt vmcnt(6)" ::: "memory"); else asm volatile("s_waitcnt vmcnt(0)" ::: "memory");
        __builtin_amdgcn_s_barrier();
        asm volatile("" ::: "memory");
        const bool st = (kt + 2 < nt);
        const bf16_t* _ga; const bf16_t* _gb; int _ld = lda0;
        {
            const int _k0 = (kt + 2) * BK; const bf16_t* _ab; int _kk;
            if (_k0 < ksplit) { _ab = A0; _ld = lda0; _kk = _k0; } else { _ab = A1; _ld = lda1; _kk = _k0 - ksplit; }
            _ga = _ab + arow * _ld + _kk + csrc; _gb = Bt + brow * ldb + _k0 + csrc;
        }
        LAS unsigned char* _la = lds + bnn + wid * 1024;
        if constexpr (MID) { if (kt * BK == ksplit) epi.mid(acc, m0 + wm * 64 + r32); }
        const LAS unsigned char* sa = lds + bcur + (wm * 64 + r32) * 128;
        const LAS unsigned char* sb = lds + bcur + A_STAGE + (wn * 64 + r32) * 128;
#define GT_LD(A0_, A1_, B0_, B1_, off) do { A0_ = *(const LAS bf16x8*)(sa + (off)); A1_ = *(const LAS bf16x8*)(sa + 32 * 128 + (off)); \
            B0_ = *(const LAS bf16x8*)(sb + (off)); B1_ = *(const LAS bf16x8*)(sb + 32 * 128 + (off)); } while (0)
#define GT_MM(A0_, A1_, B0_, B1_) do { acc[0][0] = MFMA32(B0_, A0_, acc[0][0]); acc[0][1] = MFMA32(B1_, A0_, acc[0][1]); \
            acc[1][0] = MFMA32(B0_, A1_, acc[1][0]); acc[1][1] = MFMA32(B1_, A1_, acc[1][1]); } while (0)
        bf16x8 xa0, xa1, xb0, xb1, ya0, ya1, yb0, yb1;
        GT_LD(xa0, xa1, xb0, xb1, o0);
        GT_LD(ya0, ya1, yb0, yb1, o1);
        GT_MM(xa0, xa1, xb0, xb1);
        __builtin_amdgcn_sched_barrier(0);
        if (st) { __builtin_amdgcn_global_load_lds((const unsigned*)(_ga), (LAS unsigned*)(_la), 16, 0, 0);
                  __builtin_amdgcn_global_load_lds((const unsigned*)(_ga + (size_t)64 * _ld), (LAS unsigned*)(_la + 8192), 16, 0, 0); }
        GT_LD(xa0, xa1, xb0, xb1, o2);
        __builtin_amdgcn_sched_barrier(0);
        GT_MM(ya0, ya1, yb0, yb1);
        __builtin_amdgcn_sched_barrier(0);
        if (st) { __builtin_amdgcn_global_load_lds((const unsigned*)(_ga + (size_t)128 * _ld), (LAS unsigned*)(_la + 2 * 8192), 16, 0, 0);
                  __builtin_amdgcn_global_load_lds((const unsigned*)(_ga + (size_t)192 * _ld), (LAS unsigned*)(_la + 3 * 8192), 16, 0, 0); }
        GT_LD(ya0, ya1, yb0, yb1, o3);
        __builtin_amdgcn_sched_barrier(0);
        GT_MM(xa0, xa1, xb0, xb1);
        __builtin_amdgcn_sched_barrier(0);
        if (st) { __builtin_amdgcn_global_load_lds((const unsigned*)(_gb), (LAS unsigned*)(_la + A_STAGE), 16, 0, 0);
                  __builtin_amdgcn_global_load_lds((const unsigned*)(_gb + (size_t)64 * ldb), (LAS unsigned*)(_la + A_STAGE + 8192), 16, 0, 0); }
        __builtin_amdgcn_sched_barrier(0);
        GT_MM(ya0, ya1, yb0, yb1);
#undef GT_LD
#undef GT_MM
        { const int t_ = bcur; bcur = bnxt; bnxt = bnn; bnn = t_; }
    }
    asm volatile("" ::: "memory");
    __builtin_amdgcn_s_barrier();
    asm volatile("" ::: "memory");
#undef GT_STAGE
    epi.run(acc, m0 + wm * 64, n0 + wn * 64, r32, h);
}

struct EpiProj {
    bf16_t *Q, *Kk, *VT, *Za, *Ug, *Zs; const float* rope;
    __device__ __forceinline__ void run(const f32x16 (&acc)[2][2], int mrow0, int ncol0, int r32, int h) const {
#pragma unroll
        for (int mi = 0; mi < 2; ++mi) {
            const int row = mrow0 + mi * 32 + r32, t = row & 4095;
#pragma unroll
            for (int ni = 0; ni < 2; ++ni) {
#pragma unroll
                for (int q = 0; q < 4; ++q) {
                    const int col = ncol0 + ni * 32 + q * 8 + h * 4;
                    float v0 = acc[mi][ni][4 * q], v1 = acc[mi][ni][4 * q + 1], v2 = acc[mi][ni][4 * q + 2], v3 = acc[mi][ni][4 * q + 3];
                    if (ncol0 < 640) {
                        const int i0 = (col & 63) >> 1;
                        const f32x4 cs = *(const f32x4*)(rope + ((size_t)t * 32 + i0) * 2);
                        float o0 = v0 * cs[0] - v1 * cs[1], o1 = v1 * cs[0] + v0 * cs[1], o2 = v2 * cs[2] - v3 * cs[3], o3 = v3 * cs[2] + v2 * cs[3];
                        if (ncol0 < 512) { u32x2 w; w.x = pk_bf16(o0 * QSCALE, o1 * QSCALE); w.y = pk_bf16(o2 * QSCALE, o3 * QSCALE); *(u32x2*)(Q + (size_t)row * 512 + col) = w; }
                        else { u32x2 w; w.x = pk_bf16(o0, o1); w.y = pk_bf16(o2, o3); *(u32x2*)(Kk + (size_t)row * 128 + (col - 512)) = w; }
                    } else if (ncol0 < 768) {
                        const int c = col - 640, b = row >> 12;
                        bf16_t* p = VT + ((size_t)(b * 128 + c)) * 4096 + t;
                        p[0] = to_bf16(v0); p[4096] = to_bf16(v1); p[8192] = to_bf16(v2); p[12288] = to_bf16(v3);
                    } else {
                        u32x2 w; w.x = pk_bf16(v0, v1); w.y = pk_bf16(v2, v3);
                        if (ncol0 < 1280) *(u32x2*)(Za + (size_t)row * 512 + (col - 768)) = w;
                        else if (ncol0 < 1792) { const int c = col - 1280; *(u32x2*)(Ug + ((size_t)(c >> 4) * 16384 + row) * 16 + (c & 15)) = w; }
                        else *(u32x2*)(Zs + (size_t)row * 512 + (col - 1792)) = w;
                    }
                }
            }
        }
    }
};
struct EpiSScan {
    LAS unsigned char* lds; const float* lam; bf16_t* Xin; int g, b, dir;
    __device__ __forceinline__ void run(const f32x16 (&acc)[2][2], int mrow0, int ncol0, int r32, int h) const {
        const int lrow0 = mrow0 - b * 256, lcol0 = ncol0 - dir * 128;
#pragma unroll
        for (int mi = 0; mi < 2; ++mi) {
            const int row = lrow0 + mi * 32 + r32;
#pragma unroll
            for (int ni = 0; ni < 2; ++ni)
#pragma unroll
                for (int q = 0; q < 4; ++q) {
                    const int col = lcol0 + ni * 32 + 16 * h + 4 * q;
                    *(LAS f32x4*)(lds + row * SLDS_ROW + col * 4) = (f32x4){acc[mi][ni][4 * q], acc[mi][ni][4 * q + 1], acc[mi][ni][4 * q + 2], acc[mi][ni][4 * q + 3]};
                }
        }
        __syncthreads();
        int tid = threadIdx.x; asm volatile("" : "+v"(tid));
        const int seg = __builtin_amdgcn_readfirstlane(tid >> 6), p = tid & 63;
        LAS f32x2* E = (LAS f32x2*)(lds + LDS_SCAN_E);
        const f32x2 lm = *(const f32x2*)(lam + ((size_t)(g * 2 + dir) * 64 + p) * 2);
        const f32x2 lm32 = *(const f32x2*)(lam + 8192 + ((size_t)(g * 2 + dir) * 64 + p) * 2);
        const LAS unsigned char* Sp = lds + p * 8;
        bf16_t* Xp = Xin + ((size_t)g * 1024 + b * 256) * 256 + dir * 128 + 2 * p;
        float er = 0.f, ei = 0.f;
#pragma unroll 8
        for (int i = 0; i < 32; ++i) {
            const int c = dir == 0 ? seg * 32 + i : seg * 32 + 31 - i;
            const f32x2 sv = *(const LAS f32x2*)(Sp + c * SLDS_ROW);
            const float nr = lm.x * er - lm.y * ei + sv.x, ni = lm.x * ei + lm.y * er + sv.y;
            er = nr; ei = ni;
        }
        E[seg * 64 + p] = (f32x2){er, ei};
        __syncthreads();
        float cr = 0.f, ci = 0.f;
        if (dir == 0) { for (int s2 = 0; s2 < seg; ++s2) { const f32x2 e = E[s2 * 64 + p]; const float nr = lm32.x * cr - lm32.y * ci + e.x, ni = lm32.x * ci + lm32.y * cr + e.y; cr = nr; ci = ni; } }
        else { for (int s2 = 7; s2 > seg; --s2) { const f32x2 e = E[s2 * 64 + p]; const float nr = lm32.x * cr - lm32.y * ci + e.x, ni = lm32.x * ci + lm32.y * cr + e.y; cr = nr; ci = ni; } }
#pragma unroll 8
        for (int i = 0; i < 32; ++i) {
            const int c = dir == 0 ? seg * 32 + i : seg * 32 + 31 - i;
            const f32x2 sv = *(const LAS f32x2*)(Sp + c * SLDS_ROW);
            *(unsigned*)(Xp + (size_t)c * 256) = pk_bf16(cr, ci);
            const float nr = lm.x * cr - lm.y * ci + sv.x, ni = lm.x * ci + lm.y * cr + sv.y;
            cr = nr; ci = ni;
        }
        __syncthreads();
    }
};
struct EpiY {
    bf16_t* G; int g;
    __device__ __forceinline__ void run(const f32x16 (&acc)[2][2], int mrow0, int ncol0, int r32, int h) const {
#pragma unroll
        for (int mi = 0; mi < 2; ++mi) {
            const int row = mrow0 + mi * 32 + r32;
#pragma unroll
            for (int ni = 0; ni < 2; ++ni) {
                const int pos = (ncol0 + ni * 32 + 16 * h) >> 4;
                unsigned w[8];
#pragma unroll
                for (int e = 0; e < 8; ++e) w[e] = pk_bf16(gelu_tanh(acc[mi][ni][2 * e]), gelu_tanh(acc[mi][ni][2 * e + 1]));
                bf16_t* p = G + ((size_t)row * 16 + pos) * 512 + g * 16;
                *(u32x4*)p = (u32x4){w[0], w[1], w[2], w[3]}; *(u32x4*)(p + 8) = (u32x4){w[4], w[5], w[6], w[7]};
            }
        }
    }
};
struct EpiGlu {
    const bf16_t *G, *Zs; const float* bglu; bf16_t* Ys; float* ssqS;
    __device__ __forceinline__ void run(const f32x16 (&acc)[2][2], int mrow0, int ncol0, int r32, int h) const {
        f32x4 bq[2][4];
#pragma unroll
        for (int ni = 0; ni < 2; ++ni)
#pragma unroll
            for (int q = 0; q < 4; ++q) bq[ni][q] = *(const f32x4*)(bglu + ncol0 + ni * 32 + 16 * h + 4 * q);
#pragma unroll
        for (int mi = 0; mi < 2; ++mi) {
            const int row = mrow0 + mi * 32 + r32; float ssq = 0.f;
#pragma unroll
            for (int ni = 0; ni < 2; ++ni) {
                const int col = ncol0 + ni * 32 + 16 * h;
                const u32x4 g0 = *(const u32x4*)(G + (size_t)row * 512 + col), g1 = *(const u32x4*)(G + (size_t)row * 512 + col + 8);
                const u32x4 z0 = *(const u32x4*)(Zs + (size_t)row * 512 + col), z1 = *(const u32x4*)(Zs + (size_t)row * 512 + col + 8);
                const unsigned gg[8] = {g0.x, g0.y, g0.z, g0.w, g1.x, g1.y, g1.z, g1.w}, zz[8] = {z0.x, z0.y, z0.z, z0.w, z1.x, z1.y, z1.z, z1.w};
                unsigned w[8];
#pragma unroll
                for (int e = 0; e < 8; ++e) {
                    const float y0 = bf_lo(gg[e]) * sigmoidf_(acc[mi][ni][2 * e] + bq[ni][e >> 1][(e & 1) * 2]) * siluf_(bf_lo(zz[e]));
                    const float y1 = bf_hi(gg[e]) * sigmoidf_(acc[mi][ni][2 * e + 1] + bq[ni][e >> 1][(e & 1) * 2 + 1]) * siluf_(bf_hi(zz[e]));
                    ssq += y0 * y0 + y1 * y1;
                    w[e] = pk_bf16(y0, y1);
                }
                *(u32x4*)(Ys + (size_t)row * 512 + col) = (u32x4){w[0], w[1], w[2], w[3]}; *(u32x4*)(Ys + (size_t)row * 512 + col + 8) = (u32x4){w[4], w[5], w[6], w[7]};
            }
            ssq += __shfl_xor(ssq, 32);
            if (h == 0) ssqS[(size_t)row * 8 + (ncol0 >> 6)] = ssq;
        }
    }
};
__device__ __forceinline__ float rstd8(const float* p) {
    const f32x4 a = *(const f32x4*)p, b = *(const f32x4*)(p + 4);
    const float s = ((a[0] + a[1]) + (a[2] + a[3])) + ((b[0] + b[1]) + (b[2] + b[3]));
    return 1.0f / sqrtf(s * (1.0f / 512.0f) + NORM_EPS);
}
struct EpiOut {
    const float *x, *ssqA, *ssqS, *ln_g, *ln_b; float* out; unsigned long long* lnst; unsigned* cnt; unsigned target;
    __device__ __forceinline__ void mid(f32x16 (&acc)[2][2], int rowbase) const {
#pragma unroll
        for (int mi = 0; mi < 2; ++mi) {
            const int row = rowbase + mi * 32;
            const float f = rstd8(ssqA + (size_t)row * 8) / rstd8(ssqS + (size_t)row * 8);
#pragma unroll
            for (int ni = 0; ni < 2; ++ni)
#pragma unroll
                for (int r = 0; r < 16; ++r) acc[mi][ni][r] *= f;
        }
    }
    __device__ __forceinline__ void run(f32x16 (&acc)[2][2], int mrow0, int ncol0, int r32, int h) const {
#pragma unroll
        for (int mi = 0; mi < 2; ++mi) {
            const int row = mrow0 + mi * 32 + r32;
            const float rs = rstd8(ssqS + (size_t)row * 8);
            float sum = 0.f, sq = 0.f;
#pragma unroll
            for (int ni = 0; ni < 2; ++ni)
#pragma unroll
                for (int q = 0; q < 4; ++q) {
                    const int col = ncol0 + ni * 32 + q * 8 + h * 4;
                    const f32x4 xv = *(const f32x4*)(x + (size_t)row * 1024 + col);
#pragma unroll
                    for (int j = 0; j < 4; ++j) { const float hv = DN_ALPHA * xv[j] + acc[mi][ni][4 * q + j] * rs; acc[mi][ni][4 * q + j] = hv; sum += hv; sq += hv * hv; }
                }
            sum += __shfl_xor(sum, 32); sq += __shfl_xor(sq, 32);
            if (h == 0) __hip_atomic_store(lnst + (size_t)row * 16 + (ncol0 >> 6), ((unsigned long long)__float_as_uint(sq) << 32) | __float_as_uint(sum), __ATOMIC_RELAXED, __HIP_MEMORY_SCOPE_AGENT);
        }
        asm volatile("s_waitcnt vmcnt(0)" ::: "memory");
        if ((threadIdx.x & 63) == 0) __hip_atomic_fetch_add(cnt, 1u, __ATOMIC_RELAXED, __HIP_MEMORY_SCOPE_AGENT);
        { unsigned sp = 0; while (__hip_atomic_load(cnt, __ATOMIC_RELAXED, __HIP_MEMORY_SCOPE_AGENT) < target) { __builtin_amdgcn_s_sleep(2); if (++sp > (1u << 24)) break; } }
        asm volatile("" ::: "memory");
#pragma unroll
        for (int mi = 0; mi < 2; ++mi) {
            const int row = mrow0 + mi * 32 + r32;
            float sum = 0.f, sq = 0.f;
#pragma unroll
            for (int t = 0; t < 16; ++t) { const unsigned long long w = __hip_atomic_load(lnst + (size_t)row * 16 + t, __ATOMIC_RELAXED, __HIP_MEMORY_SCOPE_AGENT); sum += __uint_as_float((unsigned)w); sq += __uint_as_float((unsigned)(w >> 32)); }
            const float mean = sum * (1.0f / 1024.0f);
            const float var = fmaxf(sq * (1.0f / 1024.0f) - mean * mean, 0.f);
            const float rstd = 1.0f / sqrtf(var + NORM_EPS);
#pragma unroll
            for (int ni = 0; ni < 2; ++ni)
#pragma unroll
                for (int q = 0; q < 4; ++q) {
                    const int col = ncol0 + ni * 32 + q * 8 + h * 4;
                    const f32x4 gg = *(const f32x4*)(ln_g + col), bb = *(const f32x4*)(ln_b + col);
                    f32x4 o;
#pragma unroll
                    for (int j = 0; j < 4; ++j) o[j] = (acc[mi][ni][4 * q + j] - mean) * rstd * gg[j] + bb[j];
                    *(f32x4*)(out + (size_t)row * 1024 + col) = o;
                }
        }
    }
};


typedef float f32x4v __attribute__((ext_vector_type(4)));
constexpr int HTB = 128 * 64 * 2;
constexpr int LDS8_TAB = 8 * HTB;
__host__ __device__ __forceinline__ int lds_byte8(int r, int c) { const int st = (r >> 4) * 2 + (c >> 5), rr = r & 15, cc = c & 31, ob = rr * 64 + cc * 2; return st * 1024 + (ob ^ (((ob >> 9) & 1) << 5)); }
__host__ __device__ __forceinline__ void stage_rc8(int b, int& R, int& C) { const int st = b / 1024, sb = b % 1024, swz = sb ^ (((sb >> 9) & 1) << 5); R = (st >> 1) * 16 + swz / 64; C = (st & 1) * 32 + (swz % 64) / 2; }
#define MFMA16(a, b, c) __builtin_amdgcn_mfma_f32_16x16x32_bf16((a), (b), (c), 0, 0, 0)

__host__ __device__ __forceinline__ int perm32_8(int rho) { const int n = rho >> 4, i = rho & 15; return 8 * (i >> 2) + 4 * n + (i & 3); }
template <class Epi, class Sched, bool MID, bool AFTER_DRAIN, bool SP2>
__device__ __forceinline__ void gemm8_phase(LAS unsigned char* lds, const bf16_t* __restrict__ A0, const bf16_t* __restrict__ A1, int lda, int ksw,
                                            const bf16_t* __restrict__ Bt, int ldb, int nt, const Sched& S, const Epi& epi) {
    int tid = threadIdx.x; asm volatile("" : "+v"(tid));
    const int lane = tid & 63, wid = __builtin_amdgcn_readfirstlane(tid >> 6), wr = wid >> 2, wc = wid & 3, fr = lane & 15, fq = lane >> 4;
    int brow, bcol;
    if (!S.get(0, brow, bcol)) return;
    unsigned voffA[2], voffB[2];
#pragma unroll
    for (int i = 0; i < 2; ++i) { int R, C; stage_rc8(tid * 16 + i * 8192, R, C); const int Rb = Epi::PERM ? ((R & ~31) + perm32_8(R & 31)) : R; voffA[i] = (unsigned)(R * lda + C) * 2u; voffB[i] = (unsigned)(Rb * ldb + C) * 2u; }
    const unsigned ldsw = (unsigned)wid * 1024u;
    const int aoff = lds_byte8(wr * 64 + fr, fq * 8), boff = lds_byte8(wc * 32 + fr, fq * 8);
    const size_t hA = (size_t)128 * lda * 2, hB = (size_t)128 * ldb * 2;
    const char* cA0 = (const char*)A0 + (size_t)brow * lda * 2; const char* cA1 = (const char*)A1 + (size_t)brow * lda * 2;
    const char* cB = (const char*)Bt + (size_t)bcol * ldb * 2;
#define G8_SA(b, h) (((b) * 2 + (h)) * HTB)
#define G8_SB(b, h) ((4 + (b) * 2 + (h)) * HTB)
#define G8_AB(kt) ((kt) < ksw ? cA0 + (size_t)(kt) * 128 : cA1 + (size_t)((kt) - ksw) * 128)
#define G8_ST(off, gp, vo) do { const char* _g = (gp); _Pragma("unroll") for (int _i = 0; _i < 2; ++_i) \
        __builtin_amdgcn_global_load_lds((const unsigned*)(_g + vo[_i]), (LAS unsigned*)(lds + (off) + ldsw + _i * 8192), 16, 0, 0); } while (0)
#define G8_LDA(dst, b, h) do { _Pragma("unroll") for (int m = 0; m < 4; ++m) _Pragma("unroll") for (int k = 0; k < 2; ++k) dst[m][k] = *(const LAS bf16x8*)(lds + G8_SA(b, h) + aoff + m * 2048 + k * 1024); } while (0)
#define G8_LDB(dst, b, h) do { _Pragma("unroll") for (int n = 0; n < 2; ++n) _Pragma("unroll") for (int k = 0; k < 2; ++k) dst[n][k] = *(const LAS bf16x8*)(lds + G8_SB(b, h) + boff + n * 2048 + k * 1024); } while (0)
#define G8_MMA(ai, bj, At_, Bt_) do { __builtin_amdgcn_s_setprio(1); _Pragma("unroll") for (int m = 0; m < 4; ++m) _Pragma("unroll") for (int n = 0; n < 2; ++n) _Pragma("unroll") for (int k = 0; k < 2; ++k) \
        acc[ai][bj][m][n] = MFMA16(Bt_[n][k], At_[m][k], acc[ai][bj][m][n]); __builtin_amdgcn_s_setprio(0); } while (0)
#define G8_WV(n) asm volatile("s_waitcnt vmcnt(" #n ")" ::: "memory")
#define G8_WL(n) asm volatile("s_waitcnt lgkmcnt(" #n ")" ::: "memory")
#define G8_BAR __builtin_amdgcn_s_barrier()
#define G8_SCHED __builtin_amdgcn_sched_barrier(0)
    f32x4v acc[2][2][4][2];
#pragma unroll
    for (int a = 0; a < 2; ++a)
#pragma unroll
        for (int b = 0; b < 2; ++b)
#pragma unroll
            for (int m = 0; m < 4; ++m)
#pragma unroll
                for (int n = 0; n < 2; ++n) acc[a][b][m][n] = (f32x4v){0.f, 0.f, 0.f, 0.f};
    bf16x8 At[4][2], B0[2][2], B1[2][2];
    if constexpr (MID) epi.pre(brow, tid);
    if constexpr (SP2) {
        G8_ST(G8_SB(0, 0), cB, voffB); G8_ST(G8_SB(0, 1), cB + hB, voffB); G8_ST(G8_SA(0, 0), cA0, voffA); G8_ST(G8_SA(0, 1), cA0 + hA, voffA);
        if (wr == 1) G8_BAR;
        G8_WV(2); G8_BAR;
        G8_ST(G8_SB(1, 0), cB + 128, voffB); G8_ST(G8_SA(1, 0), G8_AB(1), voffA); G8_ST(G8_SB(1, 1), cB + 128 + hB, voffB);
        G8_WV(6); G8_BAR;
    } else {
    G8_ST(G8_SB(0, 0), cB, voffB); G8_ST(G8_SA(0, 0), cA0, voffA); G8_ST(G8_SB(0, 1), cB + hB, voffB); G8_ST(G8_SA(0, 1), cA0 + hA, voffA);
    if (wr == 1) G8_BAR;
    G8_WV(4); G8_BAR;
    G8_ST(G8_SB(1, 0), cB + 128, voffB); G8_ST(G8_SA(1, 0), G8_AB(1), voffA); G8_ST(G8_SB(1, 1), cB + 128 + hB, voffB);
    G8_WV(6); G8_BAR;
    }
    int ui = 0;
    for (;;) {
        int nbrow, nbcol; const bool has_next = S.get(ui + 1, nbrow, nbcol);
        const char* nA = has_next ? (const char*)A0 + (size_t)nbrow * lda * 2 : cA0; const char* nB = has_next ? (const char*)Bt + (size_t)nbcol * ldb * 2 : cB;
        for (int t = 0; t < nt; t += 2) {
            const bool last = (t == nt - 2);
            const char* a1 = G8_AB(t + 1);
            const char* a2 = last ? nA : G8_AB(t + 2); const char* b2 = last ? nB : cB + (size_t)(t + 2) * 128;
            const char* a3 = last ? nA + 128 : G8_AB(t + 3); const char* b3 = last ? nB + 128 : cB + (size_t)(t + 3) * 128;
            if constexpr (MID) { if (t == ksw) epi.mid(acc, wr * 64 + fr); }
            if constexpr (SP2) {
            G8_LDB(B0, 0, 0); G8_LDB(B1, 0, 1); G8_SCHED; G8_LDA(At, 0, 0); G8_ST(G8_SA(1, 1), a1 + hA, voffA);
            G8_WV(8); G8_WL(0); G8_BAR; G8_MMA(0, 0, At, B0); G8_MMA(0, 1, At, B1); G8_BAR; G8_SCHED;
            G8_LDA(At, 0, 1); G8_ST(G8_SB(0, 0), b2, voffB); G8_ST(G8_SB(0, 1), b2 + hB, voffB); G8_ST(G8_SA(0, 0), a2, voffA);
            G8_WV(8); G8_WL(0); G8_BAR; G8_MMA(1, 0, At, B0); G8_MMA(1, 1, At, B1); G8_BAR; G8_SCHED;
            G8_LDB(B0, 1, 0); G8_LDB(B1, 1, 1); G8_SCHED; G8_LDA(At, 1, 0); G8_ST(G8_SA(0, 1), a2 + hA, voffA);
            G8_WV(8); G8_WL(0); G8_BAR; G8_MMA(0, 0, At, B0); G8_MMA(0, 1, At, B1); G8_BAR; G8_SCHED;
            G8_LDA(At, 1, 1); G8_ST(G8_SB(1, 0), b3, voffB); G8_ST(G8_SB(1, 1), b3 + hB, voffB); G8_ST(G8_SA(1, 0), a3, voffA);
            G8_WV(8); G8_WL(0); G8_BAR; G8_MMA(1, 0, At, B0); G8_MMA(1, 1, At, B1); G8_BAR; G8_SCHED;
            } else {
            G8_LDB(B0, 0, 0); G8_SCHED; G8_LDA(At, 0, 0); G8_ST(G8_SA(1, 1), a1 + hA, voffA);
            G8_WL(8); G8_BAR; G8_WL(0); G8_MMA(0, 0, At, B0); G8_BAR; G8_SCHED;
            G8_LDB(B1, 0, 1); G8_ST(G8_SB(0, 0), b2, voffB);
            G8_BAR; G8_WL(0); G8_MMA(0, 1, At, B1); G8_BAR;
            G8_LDA(At, 0, 1); G8_ST(G8_SA(0, 0), a2, voffA);
            G8_BAR; G8_WL(0); G8_MMA(1, 0, At, B0); G8_BAR; G8_SCHED;
            G8_ST(G8_SB(0, 1), b2 + hB, voffB);
            G8_WV(6); G8_BAR; G8_MMA(1, 1, At, B1); G8_BAR;
            G8_LDB(B0, 1, 0); G8_SCHED; G8_LDA(At, 1, 0); G8_ST(G8_SA(0, 1), a2 + hA, voffA);
            G8_WL(8); G8_BAR; G8_WL(0); G8_MMA(0, 0, At, B0); G8_BAR; G8_SCHED;
            G8_LDB(B1, 1, 1); G8_ST(G8_SB(1, 0), b3, voffB);
            G8_BAR; G8_WL(0); G8_MMA(0, 1, At, B1); G8_BAR;
            G8_LDA(At, 1, 1); G8_ST(G8_SA(1, 0), a3, voffA);
            G8_BAR; G8_WL(0); G8_MMA(1, 0, At, B0); G8_BAR; G8_SCHED;
            G8_ST(G8_SB(1, 1), b3 + hB, voffB);
            G8_WV(6); G8_BAR; G8_MMA(1, 1, At, B1); G8_BAR;
            }
        }
        if constexpr (!AFTER_DRAIN) { if (wr == 0) G8_BAR; }
        if constexpr (!AFTER_DRAIN) epi.run(acc, brow + wr * 64 + fr, bcol + wc * 32 + fq * (Epi::PERM ? 8 : 4), wid, lane);
        if (!has_next) break;
#pragma unroll
        for (int a = 0; a < 2; ++a)
#pragma unroll
            for (int b = 0; b < 2; ++b)
#pragma unroll
                for (int m = 0; m < 4; ++m)
#pragma unroll
                    for (int n = 0; n < 2; ++n) acc[a][b][m][n] = (f32x4v){0.f, 0.f, 0.f, 0.f};
        brow = nbrow; bcol = nbcol; cA0 = nA; cA1 = (const char*)A1 + (size_t)nbrow * lda * 2; cB = nB; ++ui;
        if constexpr (!AFTER_DRAIN) { if (wr == 1) G8_BAR; }
    }
    G8_WV(0);
    if constexpr (AFTER_DRAIN) { if (wr == 0) G8_BAR; }
    G8_BAR;
    if constexpr (AFTER_DRAIN) epi.run(acc, brow + wr * 64 + fr, bcol + wc * 32 + fq * (Epi::PERM ? 8 : 4), wid, lane);
}
struct SchedProj { int bx, G, total;
    __device__ __forceinline__ bool get(int i, int& brow, int& bcol) const { const int t_ = bx + i * G; if (t_ >= total) return false; const int t = t_ % 576; const int grp = t / 36, w = t % 36;
        brow = (grp * 4 + (w & 3)) * 256; bcol = (w >> 2) * 256; return true; } };
struct SchedP1 { int bx, G, mode;
    __device__ __forceinline__ bool get(int i, int& brow, int& bcol) const {
        if (mode == 1) { if (i > 1) return false; const int t = bx + i * 256; const int grp = t >> 5, w = t & 31; brow = (grp * 4 + (w & 3)) * 256; bcol = (w >> 2) * 256; return true; }
        if (mode == 2) { if (i != 0 || bx >= 64) return false; brow = bx * 256; bcol = 8 * 256; return true; }
        const int t = bx + i * G; if (t >= 576) return false; const int grp = t / 36, w = t % 36; brow = (grp * 4 + (w & 3)) * 256; bcol = (w >> 2) * 256; return true; } };
struct SchedOut { int bx;
    __device__ __forceinline__ bool get(int i, int& brow, int& bcol) const { if (i != 0 || bx >= 256) return false; brow = (bx >> 2) * 256; bcol = (bx & 3) * 256; return true; } };

struct EpiProj8 {
    static constexpr bool PERM = true;
    bf16_t *Q, *Kk, *VT, *Za, *Ug, *Zs; const float* rope;
    __device__ __forceinline__ void run(const f32x4v (&acc)[2][2][4][2], int row0, int col0, int wid, int lane) const {
#pragma unroll
        for (int ai = 0; ai < 2; ++ai)
#pragma unroll
            for (int m = 0; m < 4; ++m) {
                const int row = row0 + ai * 128 + m * 16, t = row & 4095;
#pragma unroll
                for (int bj = 0; bj < 2; ++bj) {
                    const int col = col0 + bj * 128;
                    const int cb = col & ~63;
                    f32x4v v0 = acc[ai][bj][m][0], v1 = acc[ai][bj][m][1];
                    if (cb < 640) {
                        const int i0 = (col & 63) >> 1;
                        const f32x4 c0 = *(const f32x4*)(rope + ((size_t)t * 32 + i0) * 2), c1 = *(const f32x4*)(rope + ((size_t)t * 32 + i0 + 2) * 2);
                        float o0 = v0[0] * c0[0] - v0[1] * c0[1], o1 = v0[1] * c0[0] + v0[0] * c0[1], o2 = v0[2] * c0[2] - v0[3] * c0[3], o3 = v0[3] * c0[2] + v0[2] * c0[3];
                        float o4 = v1[0] * c1[0] - v1[1] * c1[1], o5 = v1[1] * c1[0] + v1[0] * c1[1], o6 = v1[2] * c1[2] - v1[3] * c1[3], o7 = v1[3] * c1[2] + v1[2] * c1[3];
                        if (cb < 512) { o0 *= QSCALE; o1 *= QSCALE; o2 *= QSCALE; o3 *= QSCALE; o4 *= QSCALE; o5 *= QSCALE; o6 *= QSCALE; o7 *= QSCALE; }
                        const u32x4 w = (u32x4){pk_bf16(o0, o1), pk_bf16(o2, o3), pk_bf16(o4, o5), pk_bf16(o6, o7)};
                        if (cb < 512) *(u32x4*)(Q + (size_t)row * 512 + col) = w; else *(u32x4*)(Kk + (size_t)row * 128 + (col - 512)) = w;
                    } else if (cb < 768) {
                        const int c = col - 640, b = row >> 12;
                        bf16_t* p = VT + ((size_t)(b * 128 + c)) * 4096 + t;
                        p[0] = to_bf16(v0[0]); p[4096] = to_bf16(v0[1]); p[8192] = to_bf16(v0[2]); p[12288] = to_bf16(v0[3]);
                        p[16384] = to_bf16(v1[0]); p[20480] = to_bf16(v1[1]); p[24576] = to_bf16(v1[2]); p[28672] = to_bf16(v1[3]);
                    } else {
                        const u32x4 w = (u32x4){pk_bf16(v0[0], v0[1]), pk_bf16(v0[2], v0[3]), pk_bf16(v1[0], v1[1]), pk_bf16(v1[2], v1[3])};
                        if (cb < 1280) *(u32x4*)(Za + (size_t)row * 512 + (col - 768)) = w;
                        else if (cb < 1792) { const int c = col - 1280; *(u32x4*)(Ug + ((size_t)(c >> 4) * 16384 + row) * 16 + (c & 15)) = w; }
                        else *(u32x4*)(Zs + (size_t)row * 512 + (col - 1792)) = w;
                    }
                }
            }
    }
};
struct EpiOut8 {
    static constexpr bool PERM = false;
    LAS unsigned char* lds; const float *x, *ssqA, *ssqS, *ln_g, *ln_b; float* out; unsigned long long* lnst; unsigned* cnt; unsigned target;
    __device__ __forceinline__ void pre(int brow, int tid) const {
        if (tid < 256) { const float ra = rstd8(ssqA + (size_t)(brow + tid) * 8), rs = rstd8(ssqS + (size_t)(brow + tid) * 8); *(LAS f32x2*)(lds + LDS8_TAB + tid * 8) = (f32x2){ra / rs, rs}; }
    }
    __device__ __forceinline__ void mid(f32x4v (&acc)[2][2][4][2], int lrow) const {
#pragma unroll
        for (int ai = 0; ai < 2; ++ai)
#pragma unroll
            for (int m = 0; m < 4; ++m) {
                const float f = (*(const LAS f32x2*)(lds + LDS8_TAB + (lrow + ai * 128 + m * 16) * 8)).x;
#pragma unroll
                for (int bj = 0; bj < 2; ++bj)
#pragma unroll
                    for (int n = 0; n < 2; ++n) acc[ai][bj][m][n] *= f;
            }
    }
    __device__ __forceinline__ void run(f32x4v (&acc)[2][2][4][2], int row0, int col0, int wid, int lane) const {
        const int fq = lane >> 4, wc = wid & 3, part = ((col0 - fq * 4) >> 8) * 4 + wc;
        f32x4 xv[2][4];
#pragma unroll
        for (int c = 0; c < 4; ++c) xv[0][c] = *(const f32x4*)(x + (size_t)row0 * 1024 + col0 + (c >> 1) * 128 + (c & 1) * 16);
#pragma unroll
        for (int g = 0; g < 8; ++g) {
            const int ai = g >> 2, m = g & 3, row = row0 + ai * 128 + m * 16;
            if (g < 7) { const int row1 = row0 + ((g + 1) >> 2) * 128 + ((g + 1) & 3) * 16;
#pragma unroll
                for (int c = 0; c < 4; ++c) xv[(g + 1) & 1][c] = *(const f32x4*)(x + (size_t)row1 * 1024 + col0 + (c >> 1) * 128 + (c & 1) * 16); }
            const float rs = (*(const LAS f32x2*)(lds + LDS8_TAB + ((row & 255)) * 8)).y;
            float sum = 0.f, sq = 0.f;
#pragma unroll
            for (int c = 0; c < 4; ++c) {
                const int bj = c >> 1, n = c & 1;
                f32x4v hv;
#pragma unroll
                for (int j = 0; j < 4; ++j) { hv[j] = DN_ALPHA * xv[g & 1][c][j] + acc[ai][bj][m][n][j] * rs; sum += hv[j]; sq += hv[j] * hv[j]; }
                acc[ai][bj][m][n] = hv;
            }
            sum += __shfl_xor(sum, 16); sq += __shfl_xor(sq, 16); sum += __shfl_xor(sum, 32); sq += __shfl_xor(sq, 32);
            if (fq == 0) __hip_atomic_store(lnst + (size_t)row * 16 + part, ((unsigned long long)__float_as_uint(sq) << 32) | __float_as_uint(sum), __ATOMIC_RELAXED, __HIP_MEMORY_SCOPE_AGENT);
        }
        asm volatile("s_waitcnt vmcnt(0)" ::: "memory");
        if (lane == 0) __hip_atomic_fetch_add(cnt, 1u, __ATOMIC_RELAXED, __HIP_MEMORY_SCOPE_AGENT);
        f32x4 gg[4], bb[4];
#pragma unroll
        for (int c = 0; c < 4; ++c) { const int col = col0 + (c >> 1) * 128 + (c & 1) * 16; gg[c] = *(const f32x4*)(ln_g + col); bb[c] = *(const f32x4*)(ln_b + col); }
        { unsigned sp = 0; while (__hip_atomic_load(cnt, __ATOMIC_RELAXED, __HIP_MEMORY_SCOPE_AGENT) < target) { __builtin_amdgcn_s_sleep(2); if (++sp > (1u << 24)) break; } }
        asm volatile("" ::: "memory");
#pragma unroll
        for (int ai = 0; ai < 2; ++ai) {
            unsigned long long w[4][4];
#pragma unroll
            for (int m = 0; m < 4; ++m)
#pragma unroll
                for (int t = 0; t < 4; ++t) w[m][t] = __hip_atomic_load(lnst + (size_t)(row0 + ai * 128 + m * 16) * 16 + fq * 4 + t, __ATOMIC_RELAXED, __HIP_MEMORY_SCOPE_AGENT);
#pragma unroll
            for (int m = 0; m < 4; ++m) {
                const int row = row0 + ai * 128 + m * 16;
                float sum = 0.f, sq = 0.f;
#pragma unroll
                for (int t = 0; t < 4; ++t) { sum += __uint_as_float((unsigned)w[m][t]); sq += __uint_as_float((unsigned)(w[m][t] >> 32)); }
                sum += __shfl_xor(sum, 16); sq += __shfl_xor(sq, 16); sum += __shfl_xor(sum, 32); sq += __shfl_xor(sq, 32);
                const float mean = sum * (1.0f / 1024.0f);
                const float var = fmaxf(sq * (1.0f / 1024.0f) - mean * mean, 0.f);
                const float rstd = 1.0f / sqrtf(var + NORM_EPS);
#pragma unroll
                for (int c = 0; c < 4; ++c) {
                    const int bj = c >> 1, n = c & 1, col = col0 + bj * 128 + n * 16;
                    f32x4 o;
#pragma unroll
                    for (int j = 0; j < 4; ++j) o[j] = (acc[ai][bj][m][n][j] - mean) * rstd * gg[c][j] + bb[c][j];
                    *(f32x4*)(out + (size_t)row * 1024 + col) = o;
                }
            }
        }
    }
};

struct SsmIn { const float *a_re, *a_im, *log_dt, *b_re, *b_im, *c_re, *c_im, *ssm_d; };
__device__ __forceinline__ void ssm_tables(LAS unsigned char* lds, const SsmIn P, float* lam_, bf16_t* Ws_, bf16_t* TW_, int g, int part) {
    int tid = threadIdx.x; asm volatile("" : "+v"(tid));
    LAS f32x2* pw = (LAS f32x2*)lds;
    LAS f32x2* Bb = (LAS f32x2*)(lds + 17408);
    LAS float* Kt = (LAS float*)(lds + 17408 + 16384);
    LAS f32x2* Cc = (LAS f32x2*)(lds + 17408 + 16384 + 32768);
    __syncthreads();
    {
        const int dir = (tid >> 6) & 1, p = tid & 63, dq = tid >> 7;
        const int gi = (dir * 32 + g) * 64 + p;
        const float dt = expf(P.log_dt[dir * 32 + g]);
        const float ar = P.a_re[gi], ai = P.a_im[gi];
        for (int d = dq; d <= 16; d += 4) {
            const float mg = expf((float)d * dt * ar); float sn, cn; sincosf((float)d * dt * ai, &sn, &cn);
            pw[(dir * 64 + p) * 17 + d] = (f32x2){mg * cn, mg * sn};
        }
        if (dq == 0) {
            const float mag = expf(dt * ar);
            const float lr = mag * cosf(dt * ai), li = mag * sinf(dt * ai);
            const float den = ar * ar + ai * ai;
            const float fr = ((lr - 1.0f) * ar + li * ai) / den, fi = (li * ar - (lr - 1.0f) * ai) / den;
            for (int ch = 0; ch < 16; ++ch) {
                const float br = P.b_re[(size_t)gi * 16 + ch], bi = P.b_im[(size_t)gi * 16 + ch];
                Bb[(dir * 64 + p) * 16 + ch] = (f32x2){fr * br - fi * bi, fr * bi + fi * br};
            }
        }
        if (dq == 1 && part == 0) {
            const double dar = (double)dt * (double)ar, dai = (double)dt * (double)ai;
            { const double mg = exp(dar * 16.0); double sn, cn; sincos(dai * 16.0, &sn, &cn);
              *(f32x2*)(lam_ + ((size_t)(g * 2 + dir) * 64 + p) * 2) = (f32x2){(float)(mg * cn), (float)(mg * sn)}; }
            { const double mg = exp(dar * 512.0); double sn, cn; sincos(dai * 512.0, &sn, &cn);
              *(f32x2*)(lam_ + 8192 + ((size_t)(g * 2 + dir) * 64 + p) * 2) = (f32x2){(float)(mg * cn), (float)(mg * sn)}; }
        }
        for (int i = tid; i < 2048; i += NT) { const int d2 = i >> 10, c = (i >> 6) & 15, pp = i & 63; const size_t ci = ((size_t)(d2 * 32 + g) * 16 + c) * 64 + pp; Cc[i] = (f32x2){P.c_re[ci], P.c_im[ci]}; }
    }
    __syncthreads();
    if (part == 0) for (int task = tid; task < 2048; task += NT) {
        const int dir = task >> 10, p = (task >> 4) & 63, j = task & 15;
        const int e = dir == 0 ? 15 - j : j;
        const f32x2 pwv = pw[(dir * 64 + p) * 17 + e];
        unsigned wr[8], wi[8];
#pragma unroll
        for (int c2 = 0; c2 < 8; ++c2) {
            const f32x2 b0 = Bb[(dir * 64 + p) * 16 + 2 * c2], b1 = Bb[(dir * 64 + p) * 16 + 2 * c2 + 1];
            wr[c2] = pk_bf16(pwv.x * b0.x - pwv.y * b0.y, pwv.x * b1.x - pwv.y * b1.y);
            wi[c2] = pk_bf16(pwv.x * b0.y + pwv.y * b0.x, pwv.x * b1.y + pwv.y * b1.x);
        }
        bf16_t* dst = Ws_ + ((size_t)g * 256 + dir * 128 + 2 * p) * 256 + j * 16;
        *(u32x4*)dst = (u32x4){wr[0], wr[1], wr[2], wr[3]}; *(u32x4*)(dst + 8) = (u32x4){wr[4], wr[5], wr[6], wr[7]};
        *(u32x4*)(dst + 256) = (u32x4){wi[0], wi[1], wi[2], wi[3]}; *(u32x4*)(dst + 256 + 8) = (u32x4){wi[4], wi[5], wi[6], wi[7]};
    }
    if (part == 1) for (int task = tid; task < 2048; task += NT) {
        const int dir = task >> 10, i = (task >> 6) & 15, p = task & 63;
        const int e = dir == 0 ? i + 1 : 16 - i;
        const f32x2 pwv = pw[(dir * 64 + p) * 17 + e];
#pragma unroll 4
        for (int c = 0; c < 16; ++c) {
            const f32x2 cc = Cc[(dir * 16 + c) * 64 + p];
            const float er = cc.x * pwv.x - cc.y * pwv.y, ei = cc.x * pwv.y + cc.y * pwv.x;
            *(unsigned*)(TW_ + ((size_t)g * 256 + i * 16 + c) * 512 + 256 + dir * 128 + 2 * p) = pk_bf16(er, -ei);
        }
    }
    if (part >= 2) {
        const int dir = tid >> 8, d = (tid >> 4) & 15, c = tid & 15;
        float a[16];
#pragma unroll
        for (int ch = 0; ch < 16; ++ch) a[ch] = 0.f;
        for (int p = 0; p < 64; ++p) {
            const f32x2 cc = Cc[(dir * 16 + c) * 64 + p];
            const f32x2 pwv = pw[(dir * 64 + p) * 17 + d];
            const float er = cc.x * pwv.x - cc.y * pwv.y, ei = cc.x * pwv.y + cc.y * pwv.x;
#pragma unroll
            for (int ch = 0; ch < 16; ++ch) { const f32x2 bb = Bb[(dir * 64 + p) * 16 + ch]; a[ch] += er * bb.x - ei * bb.y; }
        }
#pragma unroll
        for (int ch = 0; ch < 16; ++ch) Kt[((dir * 16 + d) * 16 + c) * 16 + ch] = a[ch];
    }
    __syncthreads();
    if (part >= 2) for (int task = (part - 2) * 4096 + tid; task < (part - 1) * 4096; task += NT) {
        const int n = task >> 5, kg = task & 31;
        const int i = n >> 4, c = n & 15, j = kg >> 1, ch0 = (kg & 1) * 8;
        float v[8];
#pragma unroll
        for (int e = 0; e < 8; ++e) {
            float sacc = 0.f;
            if (j <= i) sacc += Kt[((0 * 16 + (i - j)) * 16 + c) * 16 + ch0 + e];
            if (j >= i) sacc += Kt[((1 * 16 + (j - i)) * 16 + c) * 16 + ch0 + e];
            if (i == j && c == ch0 + e) sacc += P.ssm_d[g * 16 + c];
            v[e] = sacc;
        }
        *(u32x4*)(TW_ + ((size_t)g * 256 + n) * 512 + kg * 8) = (u32x4){pk_bf16(v[0], v[1]), pk_bf16(v[2], v[3]), pk_bf16(v[4], v[5]), pk_bf16(v[6], v[7])};
    }
    __syncthreads();
}

__device__ __forceinline__ void phase_prologue(LAS unsigned char* lds, const Args& args) {
    int tid = threadIdx.x; asm volatile("" : "+v"(tid));
    unsigned char* ws = args.ws;
    const size_t gtid = (size_t)blockIdx.x * NT + tid, gsz = (size_t)gridDim.x * NT;
    {
        const float* x = args.in[0]; bf16_t* Xb = (bf16_t*)(ws + WS_XB);
        for (size_t i = gtid; i < (size_t)MTOK * DM / 8; i += gsz) {
            const f32x4 a = *(const f32x4*)(x + i * 8), b = *(const f32x4*)(x + i * 8 + 4);
            *(u32x4*)(Xb + i * 8) = (u32x4){pk_bf16(a[0], a[1]), pk_bf16(a[2], a[3]), pk_bf16(b[0], b[1]), pk_bf16(b[2], b[3])};
        }
    }
    {
        const float* w_in = args.in[1]; bf16_t* WinT = (bf16_t*)(ws + WS_WINT);
        for (size_t i = gtid; i < (size_t)NPROJ * 128; i += gsz) {
            const int n = (int)(i % NPROJ), kg = (int)(i / NPROJ);
            int src = n;
            if (n < 640) { const int c = n & 63; src = (n & ~63) + ((c & 1) ? 32 + (c >> 1) : (c >> 1)); }
            float v[8];
#pragma unroll
            for (int j = 0; j < 8; ++j) v[j] = w_in[(size_t)(kg * 8 + j) * NPROJ + src];
            *(u32x4*)(WinT + (size_t)n * 1024 + kg * 8) = (u32x4){pk_bf16(v[0], v[1]), pk_bf16(v[2], v[3]), pk_bf16(v[4], v[5]), pk_bf16(v[6], v[7])};
        }
    }
    {
        float* rope = (float*)(ws + WS_ROPE);
        for (size_t i = gtid; i < (size_t)4096 * 32; i += gsz) {
            const int t = (int)(i >> 5), k = (int)(i & 31);
            const float inv_freq = powf(10000.0f, -(float)k / 32.0f);
            const float ang = (float)t * inv_freq;
            double sn, cn; sincos((double)ang, &sn, &cn);
            *(f32x2*)(rope + i * 2) = (f32x2){(float)cn, (float)sn};
        }
    }
}

__device__ __forceinline__ void phase_prologue_b(LAS unsigned char* lds, const Args& args, int sb, int nsb) {
    int tid = threadIdx.x; asm volatile("" : "+v"(tid));
    unsigned char* ws = args.ws;
    const size_t gtid = (size_t)sb * NT + tid, gsz = (size_t)nsb * NT;
    {
        const SsmIn SI{args.in[3], args.in[4], args.in[5], args.in[6], args.in[7], args.in[8], args.in[9], args.in[10]};
        for (int u = sb; u < 128; u += nsb) ssm_tables(lds, SI, (float*)(ws + WS_LAM), (bf16_t*)(ws + WS_WS), (bf16_t*)(ws + WS_TW), u >> 2, u & 3);
    }
    {
        const float* w_glu = args.in[11]; bf16_t* WgluT = (bf16_t*)(ws + WS_WGLUT);
        for (size_t i = gtid; i < (size_t)512 * 64; i += gsz) {
            const int n = (int)(i & 511), kg = (int)(i >> 9);
            float v[8];
#pragma unroll
            for (int j = 0; j < 8; ++j) v[j] = w_glu[(size_t)(kg * 8 + j) * 512 + n];
            *(u32x4*)(WgluT + (size_t)n * 512 + kg * 8) = (u32x4){pk_bf16(v[0], v[1]), pk_bf16(v[2], v[3]), pk_bf16(v[4], v[5]), pk_bf16(v[6], v[7])};
        }
    }
    {
        const float* w_out = args.in[15]; const float* g_attn = args.in[13]; const float* g_ssm = args.in[14]; bf16_t* WoutT = (bf16_t*)(ws + WS_WOUTT);
        for (size_t i = gtid; i < (size_t)1024 * 128; i += gsz) {
            const int n = (int)(i & 1023), kg = (int)(i >> 10);
            float v[8];
#pragma unroll
            for (int j = 0; j < 8; ++j) { const int k = kg * 8 + j; const float gn = k < 512 ? g_attn[k] : g_ssm[k - 512]; v[j] = w_out[(size_t)k * 1024 + n] * gn; }
            *(u32x4*)(WoutT + (size_t)n * 1024 + kg * 8) = (u32x4){pk_bf16(v[0], v[1]), pk_bf16(v[2], v[3]), pk_bf16(v[4], v[5]), pk_bf16(v[6], v[7])};
        }
    }
}

constexpr int VROWB = 136;
struct AttnP { const bf16_t *Q, *Kk, *VT, *Za; const float* sink; bf16_t* Ya; float* ssqA; };
__device__ __forceinline__ void attn_item(LAS unsigned char* lds, const AttnP P, int it) {
    int tid = threadIdx.x; asm volatile("" : "+v"(tid));
    const int lane = tid & 63, hd = __builtin_amdgcn_readfirstlane(tid >> 6), kvh = hd >> 2, r32 = lane & 31, h = lane >> 5;
    const int b = it >> 6, q0 = (it & 63) * 64;
    const size_t row0 = (size_t)b * 4096 + q0;
    bf16x8 qf[2][4];
#pragma unroll
    for (int nq = 0; nq < 2; ++nq)
#pragma unroll
        for (int s = 0; s < 4; ++s) qf[nq][s] = *(const bf16x8*)(P.Q + (row0 + nq * 32 + r32) * 512 + hd * 64 + s * 16 + h * 8);
    const float sink2 = P.sink[hd] * LOG2E;
    float mrun[2] = {sink2, sink2}, lrun[2] = {1.f, 1.f};
    f32x16 O[2][2];
#pragma unroll
    for (int i = 0; i < 2; ++i)
#pragma unroll
        for (int j = 0; j < 2; ++j)
#pragma unroll
            for (int r = 0; r < 16; ++r) O[i][j][r] = 0.f;
    LAS unsigned char* Ks = lds;
    LAS unsigned char* Vs = lds + 2 * 64 * ROWB;
    const int kb_lo = (q0 >= 128) ? -2 : -(q0 >> 6), kb_hi = (q0 + 128 <= 4032) ? 2 : ((4032 - q0) >> 6);
    u32x4 pk[2], pv[2];
#define AT_LOAD(kb_) do { const int _ks = q0 + (kb_) * 64; \
        _Pragma("unroll") for (int i = 0; i < 2; ++i) { const int c = tid + i * NT; \
            pk[i] = *(const u32x4*)(P.Kk + ((size_t)b * 4096 + _ks + (c >> 4)) * 128 + (c & 15) * 8); \
            pv[i] = *(const u32x4*)(P.VT + ((size_t)(b * 128 + (c >> 3))) * 4096 + _ks + (c & 7) * 8); } } while (0)
    AT_LOAD(kb_lo);
    for (int kb = kb_lo; kb <= kb_hi; ++kb) {
        __syncthreads();
#pragma unroll
        for (int i = 0; i < 2; ++i) {
            const int c = tid + i * NT, key = c >> 4, part = c & 15;
            *(LAS u32x4*)(Ks + ((part >> 3) * 64 + key) * ROWB + (part & 7) * 16) = pk[i];
            const int rowv = c >> 3, c8 = c & 7;
            *(LAS u32x2*)(Vs + rowv * VROWB + c8 * 16) = (u32x2){pv[i].x, pv[i].y};
            *(LAS u32x2*)(Vs + rowv * VROWB + c8 * 16 + 8) = (u32x2){pv[i].z, pv[i].w};
        }
        __syncthreads();
        if (kb < kb_hi) AT_LOAD(kb + 1);
#pragma unroll
        for (int nq = 0; nq < 2; ++nq) {
            f32x16 S[2];
#pragma unroll
            for (int r = 0; r < 16; ++r) { S[0][r] = 0.f; S[1][r] = 0.f; }
#pragma unroll
            for (int s = 0; s < 4; ++s) {
                const bf16x8 k0 = *(const LAS bf16x8*)(Ks + (kvh * 64 + r32) * ROWB + s * 32 + h * 16);
                const bf16x8 k1 = *(const LAS bf16x8*)(Ks + (kvh * 64 + 32 + r32) * ROWB + s * 32 + h * 16);
                S[0] = MFMA32(k0, qf[nq][s], S[0]);
                S[1] = MFMA32(k1, qf[nq][s], S[1]);
            }
            if (kb == -2 || kb == 2) {
                int base = nq * 32 + r32 - 4 * h;
                asm volatile("" : "+v"(base));
#pragma unroll
                for (int kg = 0; kg < 2; ++kg)
#pragma unroll
                    for (int r = 0; r < 16; ++r) {
                        const int kk = kg * 32 + (r & 3) + 8 * (r >> 2);
                        const bool ok = (kb == -2) ? (kk >= base) : (kk <= base);
                        S[kg][r] = ok ? S[kg][r] : -1e30f;
                    }
            }
            float mx = S[0][0];
#pragma unroll
            for (int r = 1; r < 16; ++r) mx = fmaxf(mx, S[0][r]);
#pragma unroll
            for (int r = 0; r < 16; ++r) mx = fmaxf(mx, S[1][r]);
            mx = fmaxf(mx, __shfl_xor(mx, 32));
            const float mnew = fmaxf(mrun[nq], mx);
            const float alpha = fast_exp2(mrun[nq] - mnew);
            float rs = 0.f;
#pragma unroll
            for (int kg = 0; kg < 2; ++kg)
#pragma unroll
                for (int r = 0; r < 16; ++r) { const float p = fast_exp2(S[kg][r] - mnew); S[kg][r] = p; rs += p; }
            rs += __shfl_xor(rs, 32);
            lrun[nq] = lrun[nq] * alpha + rs; mrun[nq] = mnew;
#pragma unroll
            for (int dg = 0; dg < 2; ++dg)
#pragma unroll
                for (int r = 0; r < 16; ++r) O[dg][nq][r] *= alpha;
#pragma unroll
            for (int kg = 0; kg < 2; ++kg)
#pragma unroll
                for (int s2 = 0; s2 < 2; ++s2) {
                    const u32x4 w = (u32x4){pk_bf16(S[kg][8 * s2], S[kg][8 * s2 + 1]), pk_bf16(S[kg][8 * s2 + 2], S[kg][8 * s2 + 3]),
                                            pk_bf16(S[kg][8 * s2 + 4], S[kg][8 * s2 + 5]), pk_bf16(S[kg][8 * s2 + 6], S[kg][8 * s2 + 7])};
                    const bf16x8 pf = __builtin_bit_cast(bf16x8, w);
#pragma unroll
                    for (int dg = 0; dg < 2; ++dg) {
                        const LAS unsigned char* vb = Vs + (kvh * 64 + dg * 32 + r32) * VROWB + (kg * 32 + s2 * 16 + 4 * h) * 2;
                        const u32x2 lo = *(const LAS u32x2*)vb, hi = *(const LAS u32x2*)(vb + 16);
                        const bf16x8 vf = __builtin_bit_cast(bf16x8, ((u32x4){lo.x, lo.y, hi.x, hi.y}));
                        O[dg][nq] = MFMA32(vf, pf, O[dg][nq]);
                    }
                }
        }
    }
#pragma unroll
    for (int nq = 0; nq < 2; ++nq) {
        const size_t row = row0 + nq * 32 + r32;
        const float inv = 1.0f / lrun[nq];
        float ssq = 0.f;
#pragma unroll
        for (int dg = 0; dg < 2; ++dg)
#pragma unroll
            for (int q = 0; q < 4; ++q) {
                const int d = hd * 64 + dg * 32 + q * 8 + h * 4;
                const u32x2 zw = *(const u32x2*)(P.Za + row * 512 + d);
                const float y0 = O[dg][nq][4 * q] * inv * siluf_(bf_lo(zw.x)), y1 = O[dg][nq][4 * q + 1] * inv * siluf_(bf_hi(zw.x));
                const float y2 = O[dg][nq][4 * q + 2] * inv * siluf_(bf_lo(zw.y)), y3 = O[dg][nq][4 * q + 3] * inv * siluf_(bf_hi(zw.y));
                ssq += (y0 * y0 + y1 * y1) + (y2 * y2 + y3 * y3);
                u32x2 w; w.x = pk_bf16(y0, y1); w.y = pk_bf16(y2, y3);
                *(u32x2*)(P.Ya + row * 512 + d) = w;
            }
        ssq += __shfl_xor(ssq, 32);
        if (h == 0) P.ssqA[row * 8 + hd] = ssq;
    }
}

#ifndef G8_SP2
#define G8_SP2 true
#endif
constexpr int NPHASE = 6;
#ifndef REP0
#define REP0 1
#endif
#ifndef REP1
#define REP1 1
#endif
#ifndef REP2
#define REP2 1
#endif
#ifndef REP3
#define REP3 1
#endif
#ifndef REP4
#define REP4 1
#endif
#ifndef REP5
#define REP5 1
#endif
#ifndef REP6
#define REP6 1
#endif
__global__ void __launch_bounds__(NT) fwd_kernel(Args args) {
    extern __shared__ __attribute__((aligned(16))) unsigned char lds_raw[];
    LAS unsigned char* lds = (LAS unsigned char*)lds_raw;
    const int tid = threadIdx.x;
    unsigned char* ws = args.ws;
    volatile LAS unsigned* st = (volatile LAS unsigned*)(lds + LDS_MAIN2);
    if (tid < 16) st[tid] = 0u;
    __syncthreads();
    const int lo = args.ph_lo, hi = args.ph_hi;
    XcdBarrier bar; bar.bar = (unsigned*)(ws + WS_BAR); bar.x = 0; bar.st = st;
    if (hi - lo > 1) bar = xcd_barrier_post((unsigned*)(ws + WS_BAR), st);
    if (args.never) cg::this_grid().sync();
#ifndef ONLY
#define ONLY -1
#endif
#ifndef PHMASK
#define PHMASK 255
#endif
#define IN(k) (((PHMASK >> (k)) & 1) && (ONLY < 0 || ONLY == (k)) && lo <= (k) && (k) < hi)
#define SEAM(k) do { if (IN(k) && IN((k) + 1)) xcd_barrier(bar); } while (0)
    const int G = gridDim.x, bx = (gridDim.x % 8 == 0) ? (int)((blockIdx.x % 8) * (gridDim.x / 8) + blockIdx.x / 8) : (int)blockIdx.x;

    if (IN(0)) for (int rep = 0; rep < REP0; ++rep) phase_prologue(lds, args);
    SEAM(0);
    const bool fast = false;
    unsigned* evt = (unsigned*)(ws + WS_BAR) + 64;
    if (IN(1)) {
        const bf16_t* Xb = (const bf16_t*)(ws + WS_XB); const bf16_t* WinT = (const bf16_t*)(ws + WS_WINT);
        EpiProj8 E8{(bf16_t*)(ws + WS_Q), (bf16_t*)(ws + WS_K), (bf16_t*)(ws + WS_VT), (bf16_t*)(ws + WS_ZA), (bf16_t*)(ws + WS_UG), (bf16_t*)(ws + WS_ZS), (const float*)(ws + WS_ROPE)};
#pragma clang loop unroll(disable)
        for (int stage = 0; stage < (fast ? 2 : 1); ++stage) {
            const SchedP1 SP{bx, G, fast ? stage + 1 : 0};
            gemm8_phase<EpiProj8, SchedP1, false, false, G8_SP2>(lds, Xb, Xb, 1024, 1 << 20, WinT, 1024, 16, SP, E8);
            if (stage == 0) {
                if (fast) { if (bx >= 64) phase_prologue_b(lds, args, bx - 64, 192); }
                else { int ntile = 0; for (int t_ = bx; t_ < 576; t_ += G) ++ntile; const int nr = (576 + G - 1) / G;
                    if (ntile < nr || G >= 576) { int nshort = nr * G - 576, first = G - nshort; if (nshort <= 0 || nshort > G) { nshort = G; first = 0; } if (bx >= first) phase_prologue_b(lds, args, bx - first, nshort); } }
                if (fast) {
                    asm volatile("s_waitcnt vmcnt(0)" ::: "memory");
                    __syncthreads();
                    if (tid == 0) { __builtin_amdgcn_fence(__ATOMIC_RELEASE, "agent"); asm volatile("s_waitcnt vmcnt(0)" ::: "memory"); (void)xb_add(evt, 1u); }
                }
            }
        }
    }
    if (fast) {
        if (tid == 0) { XB_SPIN(xb_ld(evt) < 256u, (unsigned*)(ws + WS_BAR)); __builtin_amdgcn_fence(__ATOMIC_ACQUIRE, "agent"); asm volatile("s_waitcnt vmcnt(0)" ::: "memory"); }
        __syncthreads();
    } else SEAM(1);
    if (IN(2)) {
        const AttnP AP{(const bf16_t*)(ws + WS_Q), (const bf16_t*)(ws + WS_K), (const bf16_t*)(ws + WS_VT), (const bf16_t*)(ws + WS_ZA), args.in[2], (bf16_t*)(ws + WS_YA), (float*)(ws + WS_SSQA)};
        int a0 = bx, as_ = G, an = (256 - bx + G - 1) / G, t0 = bx, ts = G, tn = (256 - bx + G - 1) / G;
        if (bx >= 256) { an = 0; tn = 0; }
        if (fast) { const int wi = bx - 64; a0 = wi; as_ = 192; an = wi < 0 ? 0 : (wi < 64 ? 2 : 1); t0 = 2 * (wi - 64); ts = 1; tn = wi >= 64 ? 2 : 0; }
#pragma clang loop unroll(disable)
        for (int k = 0; k < an; ++k) attn_item(lds, AP, a0 + k * as_);
        __syncthreads();
#pragma clang loop unroll(disable)
        for (int k = 0; k < tn; ++k) { const int t = t0 + k * ts; const int g = t >> 3, mt = (t >> 1) & 3, nt_ = t & 1;
            EpiSScan E{lds, (const float*)(ws + WS_LAM), (bf16_t*)(ws + WS_XIN), g, mt, nt_};
            const bf16_t* A = (const bf16_t*)(ws + WS_UG) + (size_t)g * 16384 * 16;
            gemm_tile<EpiSScan, false>(lds, A, 256, A, 256, 1 << 30, (const bf16_t*)(ws + WS_WS) + (size_t)g * 256 * 256, 256, 256, mt * BM, nt_ * BN, E); }
    }
    SEAM(2);
    if (IN(3)) {
        for (int t_ = bx; t_ < 256 * REP4; t_ += G) { const int t = t_ & 255; const int g = t >> 3, mt = (t >> 1) & 3, nt_ = t & 1;
            EpiY E{(bf16_t*)(ws + WS_G), g};
            gemm_tile<EpiY, false>(lds, (const bf16_t*)(ws + WS_UG) + (size_t)g * 16384 * 16, 256, (const bf16_t*)(ws + WS_XIN) + (size_t)g * 1024 * 256, 256, 256, (const bf16_t*)(ws + WS_TW) + (size_t)g * 256 * 512, 512, 512, mt * BM, nt_ * BN, E); }
    }
    SEAM(3);
    if (IN(4)) {
        EpiGlu E{(const bf16_t*)(ws + WS_G), (const bf16_t*)(ws + WS_ZS), args.in[12], (bf16_t*)(ws + WS_YS), (float*)(ws + WS_SSQS)};
        const bf16_t* Gp = (const bf16_t*)(ws + WS_G); const bf16_t* WgluT = (const bf16_t*)(ws + WS_WGLUT);
        for (int t_ = bx; t_ < 64 * 4 * REP5; t_ += G) { const int t = t_ & 255; const int mt = t >> 2, nt_ = t & 3;
            gemm_tile<EpiGlu, false>(lds, Gp, 512, Gp, 512, 1 << 30, WgluT, 512, 512, mt * BM, nt_ * BN, E); }
    }
    SEAM(4);
    if (IN(5)) {
        const bf16_t* Ya = (const bf16_t*)(ws + WS_YA); const bf16_t* Ys = (const bf16_t*)(ws + WS_YS); const bf16_t* WoutT = (const bf16_t*)(ws + WS_WOUTT);
        if (bx < 256) { const int mt = bx >> 2;
            EpiOut8 E{lds, args.in[0], (const float*)(ws + WS_SSQA), (const float*)(ws + WS_SSQS), args.in[16], args.in[17], args.out, (unsigned long long*)(ws + WS_LNST),
                      (unsigned*)(ws + WS_CNT) + mt * 64, 32u};
            const SchedOut SO{bx};
            gemm8_phase<EpiOut8, SchedOut, true, true, G8_SP2>(lds, Ya, Ys, 512, 8, WoutT, 1024, 16, SO, E); }
    }
#undef IN
#undef SEAM
}

extern "C" void kernel_launch(void* const* d_in, const int* in_sizes, int n_in, void* d_out, int out_size, void* d_ws, size_t ws_size, hipStream_t stream) {
    static int grid = 0;
    if (grid == 0) {
        if (n_in != 18 || ws_size < WS_END) { fprintf(stderr, "kernel_launch: unexpected inputs (n_in %d, ws %zu, need %zu)\n", n_in, ws_size, (size_t)WS_END); grid = -1; return; }
        int dev = 0, cus = 0, per_cu = 0;
        hipGetDevice(&dev);
        hipDeviceGetAttribute(&cus, hipDeviceAttributeMultiprocessorCount, dev);
        if (hipFuncSetAttribute((const void*)fwd_kernel, hipFuncAttributeMaxDynamicSharedMemorySize, LDS_BYTES) != hipSuccess) { fprintf(stderr, "kernel_launch: hipFuncSetAttribute failed\n"); grid = -1; return; }
        if (hipOccupancyMaxActiveBlocksPerMultiprocessor(&per_cu, (const void*)fwd_kernel, NT, LDS_BYTES) != hipSuccess || per_cu < 1) { fprintf(stderr, "kernel_launch: occupancy query says %d\n", per_cu); per_cu = 1; }
        (void)hipGetLastError();
        grid = cus;
    }
    if (grid < 0) return;
    (void)hipMemsetAsync((char*)d_ws + WS_BAR, 0, 32768, stream);
    Args a{};
    for (int i = 0; i < 18; ++i) a.in[i] = (const float*)d_in[i];
    a.out = (float*)d_out; a.ws = (unsigned char*)d_ws; a.never = 0; a.pad = 0;
#if N_LAUNCH_MODE == 1
    for (int ph = 0; ph < NPHASE; ++ph) {
        a.ph_lo = ph; a.ph_hi = ph + 1;
        hipLaunchKernelGGL(fwd_kernel, dim3(grid), dim3(NT), LDS_BYTES, stream, a);
    }
#else
    a.ph_lo = 0; a.ph_hi = NPHASE;
    void* kargs[] = {&a};
    hipError_t e = hipLaunchCooperativeKernel((const void*)fwd_kernel, dim3(grid), dim3(NT), kargs, LDS_BYTES, stream);
    if (e != hipSuccess) fprintf(stderr, "kernel_launch: cooperative launch failed: %s (grid %d)\n", hipGetErrorString(e), grid);
#endif
}
```

```cpp
#include <hip/hip_runtime.h>
#include <hip/hip_cooperative_groups.h>
#include <cstdint>
#include <cstdio>
namespace cg = cooperative_groups;

#ifndef N_LAUNCH_MODE
#define N_LAUNCH_MODE 0
#endif

typedef unsigned short bf16_t;
typedef short bf16x8 __attribute__((ext_vector_type(8)));
typedef float f32x16 __attribute__((ext_vector_type(16)));
typedef float f32x4 __attribute__((ext_vector_type(4)));
typedef float f32x2 __attribute__((ext_vector_type(2)));
typedef unsigned u32x4 __attribute__((ext_vector_type(4)));
typedef unsigned u32x2 __attribute__((ext_vector_type(2)));
#define LAS __attribute__((address_space(3)))

constexpr int NT = 512;
constexpr int SEQ = 4096, DM = 1024, MTOK = 16384, NPROJ = 2304;
constexpr float LOG2E = 1.4426950408889634f;
constexpr float QSCALE = 0.125f * LOG2E;
constexpr float NORM_EPS = 1e-5f;
constexpr float DN_ALPHA = 1.189207115002721f;

constexpr size_t WS_BAR = 0;
constexpr size_t WS_CNT = 16384;
constexpr size_t WS_WINT = 32768;
constexpr size_t WS_WGLUT = WS_WINT + (size_t)2304 * 1024 * 2;
constexpr size_t WS_WOUTT = WS_WGLUT + (size_t)512 * 512 * 2;
constexpr size_t WS_ROPE = WS_WOUTT + (size_t)1024 * 1024 * 2;
constexpr size_t WS_LAM = WS_ROPE + (size_t)4096 * 32 * 8;
constexpr size_t WS_WS = WS_LAM + 65536;
constexpr size_t WS_TW = WS_WS + (size_t)32 * 256 * 256 * 2;
constexpr size_t WS_XB = WS_TW + (size_t)32 * 256 * 512 * 2;
constexpr size_t WS_S = WS_XB;
constexpr size_t WS_Q = WS_XB + (size_t)16384 * 1024 * 2;
constexpr size_t WS_K = WS_Q + (size_t)16384 * 512 * 2;
constexpr size_t WS_VT = WS_K + (size_t)16384 * 128 * 2;
constexpr size_t WS_ZA = WS_VT + (size_t)16384 * 128 * 2;
constexpr size_t WS_UG = WS_ZA + (size_t)16384 * 512 * 2;
constexpr size_t WS_ZS = WS_UG + (size_t)16384 * 512 * 2;
constexpr size_t WS_XIN = WS_ZS + (size_t)16384 * 512 * 2;
constexpr size_t WS_G = WS_XIN + (size_t)32 * 1024 * 256 * 2;
constexpr size_t WS_YA = WS_G + (size_t)16384 * 512 * 2;
constexpr size_t WS_YS = WS_YA + (size_t)16384 * 512 * 2;
constexpr size_t WS_SSQA = WS_YS + (size_t)16384 * 512 * 2;
constexpr size_t WS_SSQS = WS_SSQA + (size_t)16384 * 8 * 4;
constexpr size_t WS_LNST = WS_SSQS + (size_t)16384 * 8 * 4;
constexpr size_t WS_END = WS_LNST + (size_t)16384 * 16 * 2 * 4;

__device__ __forceinline__ unsigned pk_bf16(float lo, float hi) { unsigned r; asm("v_cvt_pk_bf16_f32 %0, %1, %2" : "=v"(r) : "v"(lo), "v"(hi)); return r; }
__device__ __forceinline__ bf16_t to_bf16(float v) { return (bf16_t)(pk_bf16(v, 0.f) & 0xffffu); }
__device__ __forceinline__ float bf_lo(unsigned w) { return __uint_as_float(w << 16); }
__device__ __forceinline__ float bf_hi(unsigned w) { return __uint_as_float(w & 0xffff0000u); }
__device__ __forceinline__ float fast_exp2(float x) { return __builtin_amdgcn_exp2f(x); }
__device__ __forceinline__ float sigmoidf_(float x) { return __builtin_amdgcn_rcpf(1.0f + __builtin_amdgcn_exp2f(-1.4426950408889634f * x)); }
__device__ __forceinline__ float siluf_(float x) { return x * sigmoidf_(x); }
__device__ __forceinline__ float gelu_tanh(float x) {
    const float z2 = 1.5957691216057308f * (x + 0.044715f * x * x * x);
    return x * __builtin_amdgcn_rcpf(1.0f + __builtin_amdgcn_exp2f(-1.4426950408889634f * z2));
}
#define MFMA32(a, b, c) __builtin_amdgcn_mfma_f32_32x32x16_bf16((a), (b), (c), 0, 0, 0)

#define XB_TMO      128
#define XB_XCNT(j)  (256  + 64 * (j))
#define XB_XSUB(j)  (1280 + 64 * (j))
#define XB_XGEN(j)  (2304 + 64 * (j))
#define XB_TOP      3328
#define XB_TOPGEN   3392
#define XCD_BAR_WORDS 3456
#define XB_SPIN_CAP (1u << 22)
__device__ __forceinline__ unsigned xb_ld(unsigned* p)              { return __hip_atomic_load(p, __ATOMIC_RELAXED, __HIP_MEMORY_SCOPE_AGENT); }
__device__ __forceinline__ unsigned xb_add(unsigned* p, unsigned v) { return __hip_atomic_fetch_add(p, v, __ATOMIC_RELAXED, __HIP_MEMORY_SCOPE_AGENT); }
__device__ __forceinline__ unsigned xb_xcc_id() { return (unsigned)__builtin_amdgcn_s_getreg((3 << 11) | 20) & 0xFu; }
#define XB_SPIN(cond, bar) do { unsigned _sp = 0; while (cond) { __builtin_amdgcn_s_sleep(1); \
    if ((++_sp & 255u) == 0u) { if (xb_ld(&(bar)[XB_TMO])) break; if (_sp > XB_SPIN_CAP) { atomicAdd(&(bar)[XB_TMO], 1u); break; } } } } while (0)
struct XcdBarrier { unsigned* bar; unsigned x; volatile LAS unsigned* st; };
__device__ __forceinline__ XcdBarrier xcd_barrier_post(unsigned* bar, volatile LAS unsigned* st) {
    XcdBarrier b; b.bar = bar; b.x = xb_xcc_id(); b.st = st;
    if (threadIdx.x == 0) (void)xb_add(&bar[XB_XCNT(b.x)], 1u);
    return b;
}
__device__ __forceinline__ void xcd_barrier_complete(unsigned* bar, unsigned x, unsigned& nloc, unsigned& nx) {
    const unsigned G = gridDim.x * gridDim.y * gridDim.z;
    unsigned sum, cnt, mine, sp = 0u;
    for (;;) {
        sum = 0u; cnt = 0u; mine = 0u;
#pragma unroll
        for (unsigned j = 0; j < 16; ++j) { const unsigned c = xb_ld(&bar[XB_XCNT(j)]); sum += c; cnt += (c > 0u) ? 1u : 0u; mine = (j == x) ? c : mine; }
        if (sum == G) break;
        __builtin_amdgcn_s_sleep(1);
        if ((++sp & 255u) == 0u) { if (xb_ld(&bar[XB_TMO])) break; if (sp > XB_SPIN_CAP) { atomicAdd(&bar[XB_TMO], 1u); break; } }
    }
    nloc = mine > 0u ? mine : 1u; nx = cnt > 0u ? cnt : 1u;
}
__device__ __forceinline__ void xcd_barrier(const XcdBarrier& b) {
    asm volatile("s_waitcnt vmcnt(0)" ::: "memory");
    __syncthreads();
    if (threadIdx.x == 0) {
        unsigned* bar = b.bar;
        __builtin_amdgcn_s_waitcnt(0);
        unsigned nloc = b.st[0], nx = b.st[1];
        if (nloc == 0u) { xcd_barrier_complete(bar, b.x, nloc, nx); b.st[0] = nloc; b.st[1] = nx; }
        const unsigned old = xb_add(&bar[XB_XSUB(b.x)], 1u);
        const unsigned gen = old / nloc;
        if (old + 1u == (gen + 1u) * nloc) {
            __builtin_amdgcn_fence(__ATOMIC_RELEASE, "agent");
            asm volatile("s_waitcnt vmcnt(0)" ::: "memory");
            const unsigned og = xb_add(&bar[XB_TOP], 1u);
            const unsigned tg = og / nx;
            if (og + 1u == (tg + 1u) * nx) xb_add(&bar[XB_TOPGEN], 1u);
            else XB_SPIN(xb_ld(&bar[XB_TOPGEN]) == tg, bar);
            __builtin_amdgcn_fence(__ATOMIC_ACQUIRE, "agent");
            xb_add(&bar[XB_XGEN(b.x)], 1u);
            asm volatile("s_waitcnt vmcnt(0)" ::: "memory");
        } else {
            XB_SPIN(xb_ld(&bar[XB_XGEN(b.x)]) == gen, bar);
            __builtin_amdgcn_fence(__ATOMIC_ACQUIRE, "agent");
            asm volatile("s_waitcnt vmcnt(0)" ::: "memory");
        }
    }
    __syncthreads();
}

struct Args { const float* in[18]; float* out; unsigned char* ws; int ph_lo, ph_hi, never, pad; };

constexpr int BM = 256, BN = 128, BK = 64;
constexpr int ROWB = 144;
constexpr int A_STAGE = BM * 128, B_STAGE = BN * 128, STAGE = A_STAGE + B_STAGE;
constexpr int LDS_MAIN = 3 * STAGE;
constexpr int SLDS_ROW = 528;
constexpr int LDS_SCAN_E = 256 * SLDS_ROW;
constexpr int LDS_MAIN2 = LDS_MAIN > (LDS_SCAN_E + 4096) ? LDS_MAIN : (LDS_SCAN_E + 4096);
constexpr int LDS_BYTES = LDS_MAIN2 + 64;

template <class Epi, bool MID>
__device__ __forceinline__ void gemm_tile(LAS unsigned char* lds, const bf16_t* __restrict__ A0, int lda0, const bf16_t* __restrict__ A1, int lda1, int ksplit,
                                          const bf16_t* __restrict__ Bt, int ldb, int K, int m0, int n0, const Epi& epi) {
    int tid = threadIdx.x; asm volatile("" : "+v"(tid));
    const int lane = tid & 63, wid = __builtin_amdgcn_readfirstlane(tid >> 6);
    const int wm = wid >> 1, wn = wid & 1, r32 = lane & 31, h = lane >> 5;
    const int grow = lane >> 3, gc = lane & 7;
    const int csrc = (gc ^ (((wid * 8 + grow) >> 1) & 7)) * 8;
    const int rs_ = (wid * 8 + grow) & 31, rperm = 16 * ((rs_ >> 2) & 1) + 4 * (rs_ >> 3) + (rs_ & 3);
    const size_t arow = (size_t)(m0 + wid * 8 + grow), brow = (size_t)(n0 + ((wid * 8 + grow) & ~31) + rperm);
    f32x16 acc[2][2];
#pragma unroll
    for (int i = 0; i < 2; ++i)
#pragma unroll
        for (int j = 0; j < 2; ++j)
#pragma unroll
            for (int r = 0; r < 16; ++r) acc[i][j][r] = 0.f;
    const int nt = K / BK;
#define GT_STAGE(kt, buf) do { const int _k0 = (kt) * BK; const bf16_t* _ab; int _ld, _kk; \
        if (_k0 < ksplit) { _ab = A0; _ld = lda0; _kk = _k0; } else { _ab = A1; _ld = lda1; _kk = _k0 - ksplit; } \
        const bf16_t* _ga = _ab + arow * _ld + _kk + csrc; const bf16_t* _gb = Bt + brow * ldb + _k0 + csrc; \
        LAS unsigned char* _la = lds + (buf) * STAGE + wid * 1024; \
        _Pragma("unroll") for (int _i = 0; _i < 4; ++_i) __builtin_amdgcn_global_load_lds((const unsigned*)(_ga + (size_t)_i * 64 * _ld), (LAS unsigned*)(_la + _i * 8192), 16, 0, 0); \
        _Pragma("unroll") for (int _i = 0; _i < 2; ++_i) __builtin_amdgcn_global_load_lds((const unsigned*)(_gb + (size_t)_i * 64 * ldb), (LAS unsigned*)(_la + A_STAGE + _i * 8192), 16, 0, 0); } while (0)
    const int swz = (r32 >> 1) & 7;
    const int o0 = ((0 + h) ^ swz) << 4, o1 = ((2 + h) ^ swz) << 4, o2 = ((4 + h) ^ swz) << 4, o3 = ((6 + h) ^ swz) << 4;
    int bcur = 0, bnxt = STAGE, bnn = 2 * STAGE;
    GT_STAGE(0, 0);
    if (nt > 1) GT_STAGE(1, 1);
    for (int kt = 0; kt < nt; ++kt) {
        if (kt + 1 < nt) asm volatile("s_waitcnt vmcnt(6)" ::: "memory"); else asm volatile("s_waitcnt vmcnt(0)" ::: "memory");
        __builtin_amdgcn_s_barrier();
        asm volatile("" ::: "memory");
        const bool st = (kt + 2 < nt);
        const bf16_t* _ga; const bf16_t* _gb; int _ld = lda0;
        {
            const int _k0 = (kt + 2) * BK; const bf16_t* _ab; int _kk;
            if (_k0 < ksplit) { _ab = A0; _ld = lda0; _kk = _k0; } else { _ab = A1; _ld = lda1; _kk = _k0 - ksplit; }
            _ga = _ab + arow * _ld + _kk + csrc; _gb = Bt + brow * ldb + _k0 + csrc;
        }
        LAS unsigned char* _la = lds + bnn + wid * 1024;
        if constexpr (MID) { if (kt * BK == ksplit) epi.mid(acc, m0 + wm * 64 + r32); }
        const LAS unsigned char* sa = lds + bcur + (wm * 64 + r32) * 128;
        const LAS unsigned char* sb = lds + bcur + A_STAGE + (wn * 64 + r32) * 128;
#define GT_LD(A0_, A1_, B0_, B1_, off) do { A0_ = *(const LAS bf16x8*)(sa + (off)); A1_ = *(const LAS bf16x8*)(sa + 32 * 128 + (off)); \
            B0_ = *(const LAS bf16x8*)(sb + (off)); B1_ = *(const LAS bf16x8*)(sb + 32 * 128 + (off)); } while (0)
#define GT_MM(A0_, A1_, B0_, B1_) do { acc[0][0] = MFMA32(B0_, A0_, acc[0][0]); acc[0][1] = MFMA32(B1_, A0_, acc[0][1]); \
            acc[1][0] = MFMA32(B0_, A1_, acc[1][0]); acc[1][1] = MFMA32(B1_, A1_, acc[1][1]); } while (0)
        bf16x8 xa0, xa1, xb0, xb1, ya0, ya1, yb0, yb1;
        GT_LD(xa0, xa1, xb0, xb1, o0);
        GT_LD(ya0, ya1, yb0, yb1, o1);
        GT_MM(xa0, xa1, xb0, xb1);
        __builtin_amdgcn_sched_barrier(0);
        if (st) { __builtin_amdgcn_global_load_lds((const unsigned*)(_ga), (LAS unsigned*)(_la), 16, 0, 0);
                  __builtin_amdgcn_global_load_lds((const unsigned*)(_ga + (size_t)64 * _ld), (LAS unsigned*)(_la + 8192), 16, 0, 0); }
        GT_LD(xa0, xa1, xb0, xb1, o2);
        __builtin_amdgcn_sched_barrier(0);
        GT_MM(ya0, ya1, yb0, yb1);
        __builtin_amdgcn_sched_barrier(0);
        if (st) { __builtin_amdgcn_global_load_lds((const unsigned*)(_ga + (size_t)128 * _ld), (LAS unsigned*)(_la + 2 * 8192), 16, 0, 0);
                  __builtin_amdgcn_global_load_lds((const unsigned*)(_ga + (size_t)192 * _ld), (LAS unsigned*)(_la + 3 * 8192), 16, 0, 0); }
        GT_LD(ya0, ya1, yb0, yb1, o3);
        __builtin_amdgcn_sched_barrier(0);
        GT_MM(xa0, xa1, xb0, xb1);
        __builtin_amdgcn_sched_barrier(0);
        if (st) { __builtin_amdgcn_global_load_lds((const unsigned*)(_gb), (LAS unsigned*)(_la + A_STAGE), 16, 0, 0);
                  __builtin_amdgcn_global_load_lds((const unsigned*)(_gb + (size_t)64 * ldb), (LAS unsigned*)(_la + A_STAGE + 8192), 16, 0, 0); }
        __builtin_amdgcn_sched_barrier(0);
        GT_MM(ya0, ya1, yb0, yb1);
#undef GT_LD
#undef GT_MM
        { const int t_ = bcur; bcur = bnxt; bnxt = bnn; bnn = t_; }
    }
    asm volatile("" ::: "memory");
    __builtin_amdgcn_s_barrier();
    asm volatile("" ::: "memory");
#undef GT_STAGE
    epi.run(acc, m0 + wm * 64, n0 + wn * 64, r32, h);
}

struct EpiProj {
    bf16_t *Q, *Kk, *VT, *Za, *Ug, *Zs; const float* rope;
    __device__ __forceinline__ void run(const f32x16 (&acc)[2][2], int mrow0, int ncol0, int r32, int h) const {
#pragma unroll
        for (int mi = 0; mi < 2; ++mi) {
            const int row = mrow0 + mi * 32 + r32, t = row & 4095;
#pragma unroll
            for (int ni = 0; ni < 2; ++ni) {
#pragma unroll
                for (int q = 0; q < 4; ++q) {
                    const int col = ncol0 + ni * 32 + q * 8 + h * 4;
                    float v0 = acc[mi][ni][4 * q], v1 = acc[mi][ni][4 * q + 1], v2 = acc[mi][ni][4 * q + 2], v3 = acc[mi][ni][4 * q + 3];
                    if (ncol0 < 640) {
                        const int i0 = (col & 63) >> 1;
                        const f32x4 cs = *(const f32x4*)(rope + ((size_t)t * 32 + i0) * 2);
                        float o0 = v0 * cs[0] - v1 * cs[1], o1 = v1 * cs[0] + v0 * cs[1], o2 = v2 * cs[2] - v3 * cs[3], o3 = v3 * cs[2] + v2 * cs[3];
                        if (ncol0 < 512) { u32x2 w; w.x = pk_bf16(o0 * QSCALE, o1 * QSCALE); w.y = pk_bf16(o2 * QSCALE, o3 * QSCALE); *(u32x2*)(Q + (size_t)row * 512 + col) = w; }
                        else { u32x2 w; w.x = pk_bf16(o0, o1); w.y = pk_bf16(o2, o3); *(u32x2*)(Kk + (size_t)row * 128 + (col - 512)) = w; }
                    } else if (ncol0 < 768) {
                        const int c = col - 640, b = row >> 12;
                        bf16_t* p = VT + ((size_t)(b * 128 + c)) * 4096 + t;
                        p[0] = to_bf16(v0); p[4096] = to_bf16(v1); p[8192] = to_bf16(v2); p[12288] = to_bf16(v3);
                    } else {
                        u32x2 w; w.x = pk_bf16(v0, v1); w.y = pk_bf16(v2, v3);
                        if (ncol0 < 1280) *(u32x2*)(Za + (size_t)row * 512 + (col - 768)) = w;
                        else if (ncol0 < 1792) { const int c = col - 1280; *(u32x2*)(Ug + ((size_t)(c >> 4) * 16384 + row) * 16 + (c & 15)) = w; }
                        else *(u32x2*)(Zs + (size_t)row * 512 + (col - 1792)) = w;
                    }
                }
            }
        }
    }
};
struct EpiSScan {
    LAS unsigned char* lds; const float* lam; bf16_t* Xin; int g, b, dir;
    __device__ __forceinline__ void run(const f32x16 (&acc)[2][2], int mrow0, int ncol0, int r32, int h) const {
        const int lrow0 = mrow0 - b * 256, lcol0 = ncol0 - dir * 128;
#pragma unroll
        for (int mi = 0; mi < 2; ++mi) {
            const int row = lrow0 + mi * 32 + r32;
#pragma unroll
            for (int ni = 0; ni < 2; ++ni)
#pragma unroll
                for (int q = 0; q < 4; ++q) {
                    const int col = lcol0 + ni * 32 + 16 * h + 4 * q;
                    *(LAS f32x4*)(lds + row * SLDS_ROW + col * 4) = (f32x4){acc[mi][ni][4 * q], acc[mi][ni][4 * q + 1], acc[mi][ni][4 * q + 2], acc[mi][ni][4 * q + 3]};
                }
        }
        __syncthreads();
        int tid = threadIdx.x; asm volatile("" : "+v"(tid));
        const int seg = __builtin_amdgcn_readfirstlane(tid >> 6), p = tid & 63;
        LAS f32x2* E = (LAS f32x2*)(lds + LDS_SCAN_E);
        const f32x2 lm = *(const f32x2*)(lam + ((size_t)(g * 2 + dir) * 64 + p) * 2);
        const f32x2 lm32 = *(const f32x2*)(lam + 8192 + ((size_t)(g * 2 + dir) * 64 + p) * 2);
        const LAS unsigned char* Sp = lds + p * 8;
        bf16_t* Xp = Xin + ((size_t)g * 1024 + b * 256) * 256 + dir * 128 + 2 * p;
        float er = 0.f, ei = 0.f;
#pragma unroll 8
        for (int i = 0; i < 32; ++i) {
            const int c = dir == 0 ? seg * 32 + i : seg * 32 + 31 - i;
            const f32x2 sv = *(const LAS f32x2*)(Sp + c * SLDS_ROW);
            const float nr = lm.x * er - lm.y * ei + sv.x, ni = lm.x * ei + lm.y * er + sv.y;
            er = nr; ei = ni;
        }
        E[seg * 64 + p] = (f32x2){er, ei};
        __syncthreads();
        float cr = 0.f, ci = 0.f;
        if (dir == 0) { for (int s2 = 0; s2 < seg; ++s2) { const f32x2 e = E[s2 * 64 + p]; const float nr = lm32.x * cr - lm32.y * ci + e.x, ni = lm32.x * ci + lm32.y * cr + e.y; cr = nr; ci = ni; } }
        else { for (int s2 = 7; s2 > seg; --s2) { const f32x2 e = E[s2 * 64 + p]; const float nr = lm32.x * cr - lm32.y * ci + e.x, ni = lm32.x * ci + lm32.y * cr + e.y; cr = nr; ci = ni; } }
#pragma unroll 8
        for (int i = 0; i < 32; ++i) {
            const int c = dir == 0 ? seg * 32 + i : seg * 32 + 31 - i;
            const f32x2 sv = *(const LAS f32x2*)(Sp + c * SLDS_ROW);
            *(unsigned*)(Xp + (size_t)c * 256) = pk_bf16(cr, ci);
            const float nr = lm.x * cr - lm.y * ci + sv.x, ni = lm.x * ci + lm.y * cr + sv.y;
            cr = nr; ci = ni;
        }
        __syncthreads();
    }
};
struct EpiY {
    bf16_t* G; int g;
    __device__ __forceinline__ void run(const f32x16 (&acc)[2][2], int mrow0, int ncol0, int r32, int h) const {
#pragma unroll
        for (int mi = 0; mi < 2; ++mi) {
            const int row = mrow0 + mi * 32 + r32;
#pragma unroll
            for (int ni = 0; ni < 2; ++ni) {
                const int pos = (ncol0 + ni * 32 + 16 * h) >> 4;
                unsigned w[8];
#pragma unroll
                for (int e = 0; e < 8; ++e) w[e] = pk_bf16(gelu_tanh(acc[mi][ni][2 * e]), gelu_tanh(acc[mi][ni][2 * e + 1]));
                bf16_t* p = G + ((size_t)row * 16 + pos) * 512 + g * 16;
                *(u32x4*)p = (u32x4){w[0], w[1], w[2], w[3]}; *(u32x4*)(p + 8) = (u32x4){w[4], w[5], w[6], w[7]};
            }
        }
    }
};
struct EpiGlu {
    const bf16_t *G, *Zs; const float* bglu; bf16_t* Ys; float* ssqS;
    __device__ __forceinline__ void run(const f32x16 (&acc)[2][2], int mrow0, int ncol0, int r32, int h) const {
        f32x4 bq[2][4];
#pragma unroll
        for (int ni = 0; ni < 2; ++ni)
#pragma unroll
            for (int q = 0; q < 4; ++q) bq[ni][q] = *(const f32x4*)(bglu + ncol0 + ni * 32 + 16 * h + 4 * q);
#pragma unroll
        for (int mi = 0; mi < 2; ++mi) {
            const int row = mrow0 + mi * 32 + r32; float ssq = 0.f;
#pragma unroll
            for (int ni = 0; ni < 2; ++ni) {
                const int col = ncol0 + ni * 32 + 16 * h;
                const u32x4 g0 = *(const u32x4*)(G + (size_t)row * 512 + col), g1 = *(const u32x4*)(G + (size_t)row * 512 + col + 8);
                const u32x4 z0 = *(const u32x4*)(Zs + (size_t)row * 512 + col), z1 = *(const u32x4*)(Zs + (size_t)row * 512 + col + 8);
                const unsigned gg[8] = {g0.x, g0.y, g0.z, g0.w, g1.x, g1.y, g1.z, g1.w}, zz[8] = {z0.x, z0.y, z0.z, z0.w, z1.x, z1.y, z1.z, z1.w};
                unsigned w[8];
#pragma unroll
                for (int e = 0; e < 8; ++e) {
                    const float y0 = bf_lo(gg[e]) * sigmoidf_(acc[mi][ni][2 * e] + bq[ni][e >> 1][(e & 1) * 2]) * siluf_(bf_lo(zz[e]));
                    const float y1 = bf_hi(gg[e]) * sigmoidf_(acc[mi][ni][2 * e + 1] + bq[ni][e >> 1][(e & 1) * 2 + 1]) * siluf_(bf_hi(zz[e]));
                    ssq += y0 * y0 + y1 * y1;
                    w[e] = pk_bf16(y0, y1);
                }
                *(u32x4*)(Ys + (size_t)row * 512 + col) = (u32x4){w[0], w[1], w[2], w[3]}; *(u32x4*)(Ys + (size_t)row * 512 + col + 8) = (u32x4){w[4], w[5], w[6], w[7]};
            }
            ssq += __shfl_xor(ssq, 32);
            if (h == 0) ssqS[(size_t)row * 8 + (ncol0 >> 6)] = ssq;
        }
    }
};
__device__ __forceinline__ float rstd8(const float* p) {
    const f32x4 a = *(const f32x4*)p, b = *(const f32x4*)(p + 4);
    const float s = ((a[0] + a[1]) + (a[2] + a[3])) + ((b[0] + b[1]) + (b[2] + b[3]));
    return 1.0f / sqrtf(s * (1.0f / 512.0f) + NORM_EPS);
}
struct EpiOut {
    const float *x, *ssqA, *ssqS, *ln_g, *ln_b; float* out; unsigned long long* lnst; unsigned* cnt; unsigned target;
    __device__ __forceinline__ void mid(f32x16 (&acc)[2][2], int rowbase) const {
#pragma unroll
        for (int mi = 0; mi < 2; ++mi) {
            const int row = rowbase + mi * 32;
            const float f = rstd8(ssqA + (size_t)row * 8) / rstd8(ssqS + (size_t)row * 8);
#pragma unroll
            for (int ni = 0; ni < 2; ++ni)
#pragma unroll
                for (int r = 0; r < 16; ++r) acc[mi][ni][r] *= f;
        }
    }
    __device__ __forceinline__ void run(f32x16 (&acc)[2][2], int mrow0, int ncol0, int r32, int h) const {
#pragma unroll
        for (int mi = 0; mi < 2; ++mi) {
            const int row = mrow0 + mi * 32 + r32;
            const float rs = rstd8(ssqS + (size_t)row * 8);
            float sum = 0.f, sq = 0.f;
#pragma unroll
            for (int ni = 0; ni < 2; ++ni)
#pragma unroll
                for (int q = 0; q < 4; ++q) {
                    const int col = ncol0 + ni * 32 + q * 8 + h * 4;
                    const f32x4 xv = *(const f32x4*)(x + (size_t)row * 1024 + col);
#pragma unroll
                    for (int j = 0; j < 4; ++j) { const float hv = DN_ALPHA * xv[j] + acc[mi][ni][4 * q + j] * rs; acc[mi][ni][4 * q + j] = hv; sum += hv; sq += hv * hv; }
                }
            sum += __shfl_xor(sum, 32); sq += __shfl_xor(sq, 32);
            if (h == 0) __hip_atomic_store(lnst + (size_t)row * 16 + (ncol0 >> 6), ((unsigned long long)__float_as_uint(sq) << 32) | __float_as_uint(sum), __ATOMIC_RELAXED, __HIP_MEMORY_SCOPE_AGENT);
        }
        asm volatile("s_waitcnt vmcnt(0)" ::: "memory");
        if ((threadIdx.x & 63) == 0) __hip_atomic_fetch_add(cnt, 1u, __ATOMIC_RELAXED, __HIP_MEMORY_SCOPE_AGENT);
        { unsigned sp = 0; while (__hip_atomic_load(cnt, __ATOMIC_RELAXED, __HIP_MEMORY_SCOPE_AGENT) < target) { __builtin_amdgcn_s_sleep(2); if (++sp > (1u << 24)) break; } }
        asm volatile("" ::: "memory");
#pragma unroll
        for (int mi = 0; mi < 2; ++mi) {
            const int row = mrow0 + mi * 32 + r32;
            float sum = 0.f, sq = 0.f;
#pragma unroll
            for (int t = 0; t < 16; ++t) { const unsigned long long w = __hip_atomic_load(lnst + (size_t)row * 16 + t, __ATOMIC_RELAXED, __HIP_MEMORY_SCOPE_AGENT); sum += __uint_as_float((unsigned)w); sq += __uint_as_float((unsigned)(w >> 32)); }
            const float mean = sum * (1.0f / 1024.0f);
            const float var = fmaxf(sq * (1.0f / 1024.0f) - mean * mean, 0.f);
            const float rstd = 1.0f / sqrtf(var + NORM_EPS);
#pragma unroll
            for (int ni = 0; ni < 2; ++ni)
#pragma unroll
                for (int q = 0; q < 4; ++q) {
                    const int col = ncol0 + ni * 32 + q * 8 + h * 4;
                    const f32x4 gg = *(const f32x4*)(ln_g + col), bb = *(const f32x4*)(ln_b + col);
                    f32x4 o;
#pragma unroll
                    for (int j = 0; j < 4; ++j) o[j] = (acc[mi][ni][4 * q + j] - mean) * rstd * gg[j] + bb[j];
                    *(f32x4*)(out + (size_t)row * 1024 + col) = o;
                }
        }
    }
};


typedef float f32x4v __attribute__((ext_vector_type(4)));
constexpr int HTB = 128 * 64 * 2;
constexpr int LDS8_TAB = 8 * HTB;
__host__ __device__ __forceinline__ int lds_byte8(int r, int c) { const int st = (r >> 4) * 2 + (c >> 5), rr = r & 15, cc = c & 31, ob = rr * 64 + cc * 2; return st * 1024 + (ob ^ (((ob >> 9) & 1) << 5)); }
__host__ __device__ __forceinline__ void stage_rc8(int b, int& R, int& C) { const int st = b / 1024, sb = b % 1024, swz = sb ^ (((sb >> 9) & 1) << 5); R = (st >> 1) * 16 + swz / 64; C = (st & 1) * 32 + (swz % 64) / 2; }
#define MFMA16(a, b, c) __builtin_amdgcn_mfma_f32_16x16x32_bf16((a), (b), (c), 0, 0, 0)

__host__ __device__ __forceinline__ int perm32_8(int rho) { const int n = rho >> 4, i = rho & 15; return 8 * (i >> 2) + 4 * n + (i & 3); }
template <class Epi, class Sched, bool MID, bool AFTER_DRAIN, bool SP2>
__device__ __forceinline__ void gemm8_phase(LAS unsigned char* lds, const bf16_t* __restrict__ A0, const bf16_t* __restrict__ A1, int lda, int ksw,
                                            const bf16_t* __restrict__ Bt, int ldb, int nt, const Sched& S, const Epi& epi) {
    int tid = threadIdx.x; asm volatile("" : "+v"(tid));
    const int lane = tid & 63, wid = __builtin_amdgcn_readfirstlane(tid >> 6), wr = wid >> 2, wc = wid & 3, fr = lane & 15, fq = lane >> 4;
    int brow, bcol;
    if (!S.get(0, brow, bcol)) return;
    unsigned voffA[2], voffB[2];
#pragma unroll
    for (int i = 0; i < 2; ++i) { int R, C; stage_rc8(tid * 16 + i * 8192, R, C); const int Rb = Epi::PERM ? ((R & ~31) + perm32_8(R & 31)) : R; voffA[i] = (unsigned)(R * lda + C) * 2u; voffB[i] = (unsigned)(Rb * ldb + C) * 2u; }
    const unsigned ldsw = (unsigned)wid * 1024u;
    const int aoff = lds_byte8(wr * 64 + fr, fq * 8), boff = lds_byte8(wc * 32 + fr, fq * 8);
    const size_t hA = (size_t)128 * lda * 2, hB = (size_t)128 * ldb * 2;
    const char* cA0 = (const char*)A0 + (size_t)brow * lda * 2; const char* cA1 = (const char*)A1 + (size_t)brow * lda * 2;
    const char* cB = (const char*)Bt + (size_t)bcol * ldb * 2;
#define G8_SA(b, h) (((b) * 2 + (h)) * HTB)
#define G8_SB(b, h) ((4 + (b) * 2 + (h)) * HTB)
#define G8_AB(kt) ((kt) < ksw ? cA0 + (size_t)(kt) * 128 : cA1 + (size_t)((kt) - ksw) * 128)
#define G8_ST(off, gp, vo) do { const char* _g = (gp); _Pragma("unroll") for (int _i = 0; _i < 2; ++_i) \
        __builtin_amdgcn_global_load_lds((const unsigned*)(_g + vo[_i]), (LAS unsigned*)(lds + (off) + ldsw + _i * 8192), 16, 0, 0); } while (0)
#define G8_LDA(dst, b, h) do { _Pragma("unroll") for (int m = 0; m < 4; ++m) _Pragma("unroll") for (int k = 0; k < 2; ++k) dst[m][k] = *(const LAS bf16x8*)(lds + G8_SA(b, h) + aoff + m * 2048 + k * 1024); } while (0)
#define G8_LDB(dst, b, h) do { _Pragma("unroll") for (int n = 0; n < 2; ++n) _Pragma("unroll") for (int k = 0; k < 2; ++k) dst[n][k] = *(const LAS bf16x8*)(lds + G8_SB(b, h) + boff + n * 2048 + k * 1024); } while (0)
#define G8_MMA(ai, bj, At_, Bt_) do { __builtin_amdgcn_s_setprio(1); _Pragma("unroll") for (int m = 0; m < 4; ++m) _Pragma("unroll") for (int n = 0; n < 2; ++n) _Pragma("unroll") for (int k = 0; k < 2; ++k) \
        acc[ai][bj][m][n] = MFMA16(Bt_[n][k], At_[m][k], acc[ai][bj][m][n]); __builtin_amdgcn_s_setprio(0); } while (0)
#define G8_WV(n) asm volatile("s_waitcnt vmcnt(" #n ")" ::: "memory")
#define G8_WL(n) asm volatile("s_waitcnt lgkmcnt(" #n ")" ::: "memory")
#define G8_BAR __builtin_amdgcn_s_barrier()
#define G8_SCHED __builtin_amdgcn_sched_barrier(0)
    f32x4v acc[2][2][4][2];
#pragma unroll
    for (int a = 0; a < 2; ++a)
#pragma unroll
        for (int b = 0; b < 2; ++b)
#pragma unroll
            for (int m = 0; m < 4; ++m)
#pragma unroll
                for (int n = 0; n < 2; ++n) acc[a][b][m][n] = (f32x4v){0.f, 0.f, 0.f, 0.f};
    bf16x8 At[4][2], B0[2][2], B1[2][2];
    if constexpr (MID) epi.pre(brow, tid);
    if constexpr (SP2) {
        G8_ST(G8_SB(0, 0), cB, voffB); G8_ST(G8_SB(0, 1), cB + hB, voffB); G8_ST(G8_SA(0, 0), cA0, voffA); G8_ST(G8_SA(0, 1), cA0 + hA, voffA);
        if (wr == 1) G8_BAR;
        G8_WV(2); G8_BAR;
        G8_ST(G8_SB(1, 0), cB + 128, voffB); G8_ST(G8_SA(1, 0), G8_AB(1), voffA); G8_ST(G8_SB(1, 1), cB + 128 + hB, voffB);
        G8_WV(6); G8_BAR;
    } else {
    G8_ST(G8_SB(0, 0), cB, voffB); G8_ST(G8_SA(0, 0), cA0, voffA); G8_ST(G8_SB(0, 1), cB + hB, voffB); G8_ST(G8_SA(0, 1), cA0 + hA, voffA);
    if (wr == 1) G8_BAR;
    G8_WV(4); G8_BAR;
    G8_ST(G8_SB(1, 0), cB + 128, voffB); G8_ST(G8_SA(1, 0), G8_AB(1), voffA); G8_ST(G8_SB(1, 1), cB + 128 + hB, voffB);
    G8_WV(6); G8_BAR;
    }
    int ui = 0;
    for (;;) {
        int nbrow, nbcol; const bool has_next = S.get(ui + 1, nbrow, nbcol);
        const char* nA = has_next ? (const char*)A0 + (size_t)nbrow * lda * 2 : cA0; const char* nB = has_next ? (const char*)Bt + (size_t)nbcol * ldb * 2 : cB;
        for (int t = 0; t < nt; t += 2) {
            const bool last = (t == nt - 2);
            const char* a1 = G8_AB(t + 1);
            const char* a2 = last ? nA : G8_AB(t + 2); const char* b2 = last ? nB : cB + (size_t)(t + 2) * 128;
            const char* a3 = last ? nA + 128 : G8_AB(t + 3); const char* b3 = last ? nB + 128 : cB + (size_t)(t + 3) * 128;
            if constexpr (MID) { if (t == ksw) epi.mid(acc, wr * 64 + fr); }
            if constexpr (SP2) {
            G8_LDB(B0, 0, 0); G8_LDB(B1, 0, 1); G8_SCHED; G8_LDA(At, 0, 0); G8_ST(G8_SA(1, 1), a1 + hA, voffA);
            G8_WV(8); G8_WL(0); G8_BAR; G8_MMA(0, 0, At, B0); G8_MMA(0, 1, At, B1); G8_BAR; G8_SCHED;
            G8_LDA(At, 0, 1); G8_ST(G8_SB(0, 0), b2, voffB); G8_ST(G8_SB(0, 1), b2 + hB, voffB); G8_ST(G8_SA(0, 0), a2, voffA);
            G8_WV(8); G8_WL(0); G8_BAR; G8_MMA(1, 0, At, B0); G8_MMA(1, 1, At, B1); G8_BAR; G8_SCHED;
            G8_LDB(B0, 1, 0); G8_LDB(B1, 1, 1); G8_SCHED; G8_LDA(At, 1, 0); G8_ST(G8_SA(0, 1), a2 + hA, voffA);
            G8_WV(8); G8_WL(0); G8_BAR; G8_MMA(0, 0, At, B0); G8_MMA(0, 1, At, B1); G8_BAR; G8_SCHED;
            G8_LDA(At, 1, 1); G8_ST(G8_SB(1, 0), b3, voffB); G8_ST(G8_SB(1, 1), b3 + hB, voffB); G8_ST(G8_SA(1, 0), a3, voffA);
            G8_WV(8); G8_WL(0); G8_BAR; G8_MMA(1, 0, At, B0); G8_MMA(1, 1, At, B1); G8_BAR; G8_SCHED;
            } else {
            G8_LDB(B0, 0, 0); G8_SCHED; G8_LDA(At, 0, 0); G8_ST(G8_SA(1, 1), a1 + hA, voffA);
            G8_WL(8); G8_BAR; G8_WL(0); G8_MMA(0, 0, At, B0); G8_BAR; G8_SCHED;
            G8_LDB(B1, 0, 1); G8_ST(G8_SB(0, 0), b2, voffB);
            G8_BAR; G8_WL(0); G8_MMA(0, 1, At, B1); G8_BAR;
            G8_LDA(At, 0, 1); G8_ST(G8_SA(0, 0), a2, voffA);
            G8_BAR; G8_WL(0); G8_MMA(1, 0, At, B0); G8_BAR; G8_SCHED;
            G8_ST(G8_SB(0, 1), b2 + hB, voffB);
            G8_WV(6); G8_BAR; G8_MMA(1, 1, At, B1); G8_BAR;
            G8_LDB(B0, 1, 0); G8_SCHED; G8_LDA(At, 1, 0); G8_ST(G8_SA(0, 1), a2 + hA, voffA);
            G8_WL(8); G8_BAR; G8_WL(0); G8_MMA(0, 0, At, B0); G8_BAR; G8_SCHED;
            G8_LDB(B1, 1, 1); G8_ST(G8_SB(1, 0), b3, voffB);
            G8_BAR; G8_WL(0); G8_MMA(0, 1, At, B1); G8_BAR;
            G8_LDA(At, 1, 1); G8_ST(G8_SA(1, 0), a3, voffA);
            G8_BAR; G8_WL(0); G8_MMA(1, 0, At, B0); G8_BAR; G8_SCHED;
            G8_ST(G8_SB(1, 1), b3 + hB, voffB);
            G8_WV(6); G8_BAR; G8_MMA(1, 1, At, B1); G8_BAR;
            }
        }
        if constexpr (!AFTER_DRAIN) { if (wr == 0) G8_BAR; }
        if constexpr (!AFTER_DRAIN) epi.run(acc, brow + wr * 64 + fr, bcol + wc * 32 + fq * (Epi::PERM ? 8 : 4), wid, lane);
        if (!has_next) break;
#pragma unroll
        for (int a = 0; a < 2; ++a)
#pragma unroll
            for (int b = 0; b < 2; ++b)
#pragma unroll
                for (int m = 0; m < 4; ++m)
#pragma unroll
                    for (int n = 0; n < 2; ++n) acc[a][b][m][n] = (f32x4v){0.f, 0.f, 0.f, 0.f};
        brow = nbrow; bcol = nbcol; cA0 = nA; cA1 = (const char*)A1 + (size_t)nbrow * lda * 2; cB = nB; ++ui;
        if constexpr (!AFTER_DRAIN) { if (wr == 1) G8_BAR; }
    }
    G8_WV(0);
    if constexpr (AFTER_DRAIN) { if (wr == 0) G8_BAR; }
    G8_BAR;
    if constexpr (AFTER_DRAIN) epi.run(acc, brow + wr * 64 + fr, bcol + wc * 32 + fq * (Epi::PERM ? 8 : 4), wid, lane);
}
struct SchedProj { int bx, G, total;
    __device__ __forceinline__ bool get(int i, int& brow, int& bcol) const { const int t_ = bx + i * G; if (t_ >= total) return false; const int t = t_ % 576; const int grp = t / 36, w = t % 36;
        brow = (grp * 4 + (w & 3)) * 256; bcol = (w >> 2) * 256; return true; } };
struct SchedP1 { int bx, G, mode;
    __device__ __forceinline__ bool get(int i, int& brow, int& bcol) const {
        if (mode == 1) { if (i > 1) return false; const int t = bx + i * 256; const int grp = t >> 5, w = t & 31; brow = (grp * 4 + (w & 3)) * 256; bcol = (w >> 2) * 256; return true; }
        if (mode == 2) { if (i != 0 || bx >= 64) return false; brow = bx * 256; bcol = 8 * 256; return true; }
        const int t = bx + i * G; if (t >= 576) return false; const int grp = t / 72, w = t % 72; brow = (grp * 8 + (w & 7)) * 256; bcol = (w >> 3) * 256; return true; } };
struct SchedOut { int bx;
    __device__ __forceinline__ bool get(int i, int& brow, int& bcol) const { if (i != 0 || bx >= 256) return false; brow = (bx >> 2) * 256; bcol = (bx & 3) * 256; return true; } };

struct EpiProj8 {
    static constexpr bool PERM = true;
    bf16_t *Q, *Kk, *VT, *Za, *Ug, *Zs; const float* rope;
    __device__ __forceinline__ void run(const f32x4v (&acc)[2][2][4][2], int row0, int col0, int wid, int lane) const {
#pragma unroll
        for (int ai = 0; ai < 2; ++ai)
#pragma unroll
            for (int m = 0; m < 4; ++m) {
                const int row = row0 + ai * 128 + m * 16, t = row & 4095;
#pragma unroll
                for (int bj = 0; bj < 2; ++bj) {
                    const int col = col0 + bj * 128;
                    const int cb = col & ~63;
                    f32x4v v0 = acc[ai][bj][m][0], v1 = acc[ai][bj][m][1];
                    if (cb < 640) {
                        const int i0 = (col & 63) >> 1;
                        const f32x4 c0 = *(const f32x4*)(rope + ((size_t)t * 32 + i0) * 2), c1 = *(const f32x4*)(rope + ((size_t)t * 32 + i0 + 2) * 2);
                        float o0 = v0[0] * c0[0] - v0[1] * c0[1], o1 = v0[1] * c0[0] + v0[0] * c0[1], o2 = v0[2] * c0[2] - v0[3] * c0[3], o3 = v0[3] * c0[2] + v0[2] * c0[3];
                        float o4 = v1[0] * c1[0] - v1[1] * c1[1], o5 = v1[1] * c1[0] + v1[0] * c1[1], o6 = v1[2] * c1[2] - v1[3] * c1[3], o7 = v1[3] * c1[2] + v1[2] * c1[3];
                        if (cb < 512) { o0 *= QSCALE; o1 *= QSCALE; o2 *= QSCALE; o3 *= QSCALE; o4 *= QSCALE; o5 *= QSCALE; o6 *= QSCALE; o7 *= QSCALE; }
                        const u32x4 w = (u32x4){pk_bf16(o0, o1), pk_bf16(o2, o3), pk_bf16(o4, o5), pk_bf16(o6, o7)};
                        if (cb < 512) *(u32x4*)(Q + (size_t)row * 512 + col) = w; else *(u32x4*)(Kk + (size_t)row * 128 + (col - 512)) = w;
                    } else if (cb < 768) {
                        const int c = col - 640, b = row >> 12;
                        bf16_t* p = VT + ((size_t)(b * 128 + c)) * 4096 + t;
                        p[0] = to_bf16(v0[0]); p[4096] = to_bf16(v0[1]); p[8192] = to_bf16(v0[2]); p[12288] = to_bf16(v0[3]);
                        p[16384] = to_bf16(v1[0]); p[20480] = to_bf16(v1[1]); p[24576] = to_bf16(v1[2]); p[28672] = to_bf16(v1[3]);
                    } else {
                        const u32x4 w = (u32x4){pk_bf16(v0[0], v0[1]), pk_bf16(v0[2], v0[3]), pk_bf16(v1[0], v1[1]), pk_bf16(v1[2], v1[3])};
                        if (cb < 1280) *(u32x4*)(Za + (size_t)row * 512 + (col - 768)) = w;
                        else if (cb < 1792) { const int c = col - 1280; *(u32x4*)(Ug + ((size_t)(c >> 4) * 16384 + row) * 16 + (c & 15)) = w; }
                        else *(u32x4*)(Zs + (size_t)row * 512 + (col - 1792)) = w;
                    }
                }
            }
    }
};
struct EpiOut8 {
    static constexpr bool PERM = false;
    LAS unsigned char* lds; const float *x, *ssqA, *ssqS, *ln_g, *ln_b; float* out; unsigned long long* lnst; unsigned* cnt; unsigned target;
    __device__ __forceinline__ void pre(int brow, int tid) const {
        if (tid < 256) { const float ra = rstd8(ssqA + (size_t)(brow + tid) * 8), rs = rstd8(ssqS + (size_t)(brow + tid) * 8); *(LAS f32x2*)(lds + LDS8_TAB + tid * 8) = (f32x2){ra / rs, rs}; }
    }
    __device__ __forceinline__ void mid(f32x4v (&acc)[2][2][4][2], int lrow) const {
#pragma unroll
        for (int ai = 0; ai < 2; ++ai)
#pragma unroll
            for (int m = 0; m < 4; ++m) {
                const float f = (*(const LAS f32x2*)(lds + LDS8_TAB + (lrow + ai * 128 + m * 16) * 8)).x;
#pragma unroll
                for (int bj = 0; bj < 2; ++bj)
#pragma unroll
                    for (int n = 0; n < 2; ++n) acc[ai][bj][m][n] *= f;
            }
    }
    __device__ __forceinline__ void run(f32x4v (&acc)[2][2][4][2], int row0, int col0, int wid, int lane) const {
        const int fq = lane >> 4, wc = wid & 3, part = ((col0 - fq * 4) >> 8) * 4 + wc;
        f32x4 xv[2][4];
#pragma unroll
        for (int c = 0; c < 4; ++c) xv[0][c] = *(const f32x4*)(x + (size_t)row0 * 1024 + col0 + (c >> 1) * 128 + (c & 1) * 16);
#pragma unroll
        for (int g = 0; g < 8; ++g) {
            const int ai = g >> 2, m = g & 3, row = row0 + ai * 128 + m * 16;
            if (g < 7) { const int row1 = row0 + ((g + 1) >> 2) * 128 + ((g + 1) & 3) * 16;
#pragma unroll
                for (int c = 0; c < 4; ++c) xv[(g + 1) & 1][c] = *(const f32x4*)(x + (size_t)row1 * 1024 + col0 + (c >> 1) * 128 + (c & 1) * 16); }
            const float rs = (*(const LAS f32x2*)(lds + LDS8_TAB + ((row & 255)) * 8)).y;
            float sum = 0.f, sq = 0.f;
#pragma unroll
            for (int c = 0; c < 4; ++c) {
                const int bj = c >> 1, n = c & 1;
                f32x4v hv;
#pragma unroll
                for (int j = 0; j < 4; ++j) { hv[j] = DN_ALPHA * xv[g & 1][c][j] + acc[ai][bj][m][n][j] * rs; sum += hv[j]; sq += hv[j] * hv[j]; }
                acc[ai][bj][m][n] = hv;
            }
            sum += __shfl_xor(sum, 16); sq += __shfl_xor(sq, 16); sum += __shfl_xor(sum, 32); sq += __shfl_xor(sq, 32);
            if (fq == 0) __hip_atomic_store(lnst + (size_t)row * 16 + part, ((unsigned long long)__float_as_uint(sq) << 32) | __float_as_uint(sum), __ATOMIC_RELAXED, __HIP_MEMORY_SCOPE_AGENT);
        }
        asm volatile("s_waitcnt vmcnt(0)" ::: "memory");
        if (lane == 0) __hip_atomic_fetch_add(cnt, 1u, __ATOMIC_RELAXED, __HIP_MEMORY_SCOPE_AGENT);
        f32x4 gg[4], bb[4];
#pragma unroll
        for (int c = 0; c < 4; ++c) { const int col = col0 + (c >> 1) * 128 + (c & 1) * 16; gg[c] = *(const f32x4*)(ln_g + col); bb[c] = *(const f32x4*)(ln_b + col); }
        { unsigned sp = 0; while (__hip_atomic_load(cnt, __ATOMIC_RELAXED, __HIP_MEMORY_SCOPE_AGENT) < target) { __builtin_amdgcn_s_sleep(2); if (++sp > (1u << 24)) break; } }
        asm volatile("" ::: "memory");
#pragma unroll
        for (int ai = 0; ai < 2; ++ai) {
            unsigned long long w[4][4];
#pragma unroll
            for (int m = 0; m < 4; ++m)
#pragma unroll
                for (int t = 0; t < 4; ++t) w[m][t] = __hip_atomic_load(lnst + (size_t)(row0 + ai * 128 + m * 16) * 16 + fq * 4 + t, __ATOMIC_RELAXED, __HIP_MEMORY_SCOPE_AGENT);
#pragma unroll
            for (int m = 0; m < 4; ++m) {
                const int row = row0 + ai * 128 + m * 16;
                float sum = 0.f, sq = 0.f;
#pragma unroll
                for (int t = 0; t < 4; ++t) { sum += __uint_as_float((unsigned)w[m][t]); sq += __uint_as_float((unsigned)(w[m][t] >> 32)); }
                sum += __shfl_xor(sum, 16); sq += __shfl_xor(sq, 16); sum += __shfl_xor(sum, 32); sq += __shfl_xor(sq, 32);
                const float mean = sum * (1.0f / 1024.0f);
                const float var = fmaxf(sq * (1.0f / 1024.0f) - mean * mean, 0.f);
                const float rstd = 1.0f / sqrtf(var + NORM_EPS);
#pragma unroll
                for (int c = 0; c < 4; ++c) {
                    const int bj = c >> 1, n = c & 1, col = col0 + bj * 128 + n * 16;
                    f32x4 o;
#pragma unroll
                    for (int j = 0; j < 4; ++j) o[j] = (acc[ai][bj][m][n][j] - mean) * rstd * gg[c][j] + bb[c][j];
                    *(f32x4*)(out + (size_t)row * 1024 + col) = o;
                }
            }
        }
    }
};

struct SsmIn { const float *a_re, *a_im, *log_dt, *b_re, *b_im, *c_re, *c_im, *ssm_d; };
__device__ __forceinline__ void ssm_tables(LAS unsigned char* lds, const SsmIn P, float* lam_, bf16_t* Ws_, bf16_t* TW_, int g, int part) {
    int tid = threadIdx.x; asm volatile("" : "+v"(tid));
    LAS f32x2* pw = (LAS f32x2*)lds;
    LAS f32x2* Bb = (LAS f32x2*)(lds + 17408);
    LAS float* Kt = (LAS float*)(lds + 17408 + 16384);
    LAS f32x2* Cc = (LAS f32x2*)(lds + 17408 + 16384 + 32768);
    __syncthreads();
    {
        const int dir = (tid >> 6) & 1, p = tid & 63, dq = tid >> 7;
        const int gi = (dir * 32 + g) * 64 + p;
        const float dt = expf(P.log_dt[dir * 32 + g]);
        const float ar = P.a_re[gi], ai = P.a_im[gi];
        for (int d = dq; d <= 16; d += 4) {
            const float mg = expf((float)d * dt * ar); float sn, cn; sincosf((float)d * dt * ai, &sn, &cn);
            pw[(dir * 64 + p) * 17 + d] = (f32x2){mg * cn, mg * sn};
        }
        if (dq == 0) {
            const float mag = expf(dt * ar);
            const float lr = mag * cosf(dt * ai), li = mag * sinf(dt * ai);
            const float den = ar * ar + ai * ai;
            const float fr = ((lr - 1.0f) * ar + li * ai) / den, fi = (li * ar - (lr - 1.0f) * ai) / den;
            for (int ch = 0; ch < 16; ++ch) {
                const float br = P.b_re[(size_t)gi * 16 + ch], bi = P.b_im[(size_t)gi * 16 + ch];
                Bb[(dir * 64 + p) * 16 + ch] = (f32x2){fr * br - fi * bi, fr * bi + fi * br};
            }
        }
        if (dq == 1 && part == 0) {
            const double dar = (double)dt * (double)ar, dai = (double)dt * (double)ai;
            { const double mg = exp(dar * 16.0); double sn, cn; sincos(dai * 16.0, &sn, &cn);
              *(f32x2*)(lam_ + ((size_t)(g * 2 + dir) * 64 + p) * 2) = (f32x2){(float)(mg * cn), (float)(mg * sn)}; }
            { const double mg = exp(dar * 512.0); double sn, cn; sincos(dai * 512.0, &sn, &cn);
              *(f32x2*)(lam_ + 8192 + ((size_t)(g * 2 + dir) * 64 + p) * 2) = (f32x2){(float)(mg * cn), (float)(mg * sn)}; }
        }
        for (int i = tid; i < 2048; i += NT) { const int d2 = i >> 10, c = (i >> 6) & 15, pp = i & 63; const size_t ci = ((size_t)(d2 * 32 + g) * 16 + c) * 64 + pp; Cc[i] = (f32x2){P.c_re[ci], P.c_im[ci]}; }
    }
    __syncthreads();
    if (part == 0) for (int task = tid; task < 2048; task += NT) {
        const int dir = task >> 10, p = (task >> 4) & 63, j = task & 15;
        const int e = dir == 0 ? 15 - j : j;
        const f32x2 pwv = pw[(dir * 64 + p) * 17 + e];
        unsigned wr[8], wi[8];
#pragma unroll
        for (int c2 = 0; c2 < 8; ++c2) {
            const f32x2 b0 = Bb[(dir * 64 + p) * 16 + 2 * c2], b1 = Bb[(dir * 64 + p) * 16 + 2 * c2 + 1];
            wr[c2] = pk_bf16(pwv.x * b0.x - pwv.y * b0.y, pwv.x * b1.x - pwv.y * b1.y);
            wi[c2] = pk_bf16(pwv.x * b0.y + pwv.y * b0.x, pwv.x * b1.y + pwv.y * b1.x);
        }
        bf16_t* dst = Ws_ + ((size_t)g * 256 + dir * 128 + 2 * p) * 256 + j * 16;
        *(u32x4*)dst = (u32x4){wr[0], wr[1], wr[2], wr[3]}; *(u32x4*)(dst + 8) = (u32x4){wr[4], wr[5], wr[6], wr[7]};
        *(u32x4*)(dst + 256) = (u32x4){wi[0], wi[1], wi[2], wi[3]}; *(u32x4*)(dst + 256 + 8) = (u32x4){wi[4], wi[5], wi[6], wi[7]};
    }
    if (part == 1) for (int task = tid; task < 2048; task += NT) {
        const int dir = task >> 10, i = (task >> 6) & 15, p = task & 63;
        const int e = dir == 0 ? i + 1 : 16 - i;
        const f32x2 pwv = pw[(dir * 64 + p) * 17 + e];
#pragma unroll 4
        for (int c = 0; c < 16; ++c) {
            const f32x2 cc = Cc[(dir * 16 + c) * 64 + p];
            const float er = cc.x * pwv.x - cc.y * pwv.y, ei = cc.x * pwv.y + cc.y * pwv.x;
            *(unsigned*)(TW_ + ((size_t)g * 256 + i * 16 + c) * 512 + 256 + dir * 128 + 2 * p) = pk_bf16(er, -ei);
        }
    }
    if (part >= 2) {
        const int dir = tid >> 8, d = (tid >> 4) & 15, c = tid & 15;
        float a[16];
#pragma unroll
        for (int ch = 0; ch < 16; ++ch) a[ch] = 0.f;
        for (int p = 0; p < 64; ++p) {
            const f32x2 cc = Cc[(dir * 16 + c) * 64 + p];
            const f32x2 pwv = pw[(dir * 64 + p) * 17 + d];
            const float er = cc.x * pwv.x - cc.y * pwv.y, ei = cc.x * pwv.y + cc.y * pwv.x;
#pragma unroll
            for (int ch = 0; ch < 16; ++ch) { const f32x2 bb = Bb[(dir * 64 + p) * 16 + ch]; a[ch] += er * bb.x - ei * bb.y; }
        }
#pragma unroll
        for (int ch = 0; ch < 16; ++ch) Kt[((dir * 16 + d) * 16 + c) * 16 + ch] = a[ch];
    }
    __syncthreads();
    if (part >= 2) for (int task = (part - 2) * 4096 + tid; task < (part - 1) * 4096; task += NT) {
        const int n = task >> 5, kg = task & 31;
        const int i = n >> 4, c = n & 15, j = kg >> 1, ch0 = (kg & 1) * 8;
        float v[8];
#pragma unroll
        for (int e = 0; e < 8; ++e) {
            float sacc = 0.f;
            if (j <= i) sacc += Kt[((0 * 16 + (i - j)) * 16 + c) * 16 + ch0 + e];
            if (j >= i) sacc += Kt[((1 * 16 + (j - i)) * 16 + c) * 16 + ch0 + e];
            if (i == j && c == ch0 + e) sacc += P.ssm_d[g * 16 + c];
            v[e] = sacc;
        }
        *(u32x4*)(TW_ + ((size_t)g * 256 + n) * 512 + kg * 8) = (u32x4){pk_bf16(v[0], v[1]), pk_bf16(v[2], v[3]), pk_bf16(v[4], v[5]), pk_bf16(v[6], v[7])};
    }
    __syncthreads();
}

__device__ __forceinline__ void phase_prologue(LAS unsigned char* lds, const Args& args) {
    int tid = threadIdx.x; asm volatile("" : "+v"(tid));
    unsigned char* ws = args.ws;
    const size_t gtid = (size_t)blockIdx.x * NT + tid, gsz = (size_t)gridDim.x * NT;
    {
        const float* x = args.in[0]; bf16_t* Xb = (bf16_t*)(ws + WS_XB);
        for (size_t i = gtid; i < (size_t)MTOK * DM / 8; i += gsz) {
            const f32x4 a = *(const f32x4*)(x + i * 8), b = *(const f32x4*)(x + i * 8 + 4);
            *(u32x4*)(Xb + i * 8) = (u32x4){pk_bf16(a[0], a[1]), pk_bf16(a[2], a[3]), pk_bf16(b[0], b[1]), pk_bf16(b[2], b[3])};
        }
    }
    {
        const float* w_in = args.in[1]; bf16_t* WinT = (bf16_t*)(ws + WS_WINT);
        for (size_t i = gtid; i < (size_t)NPROJ * 128; i += gsz) {
            const int n = (int)(i % NPROJ), kg = (int)(i / NPROJ);
            int src = n;
            if (n < 640) { const int c = n & 63; src = (n & ~63) + ((c & 1) ? 32 + (c >> 1) : (c >> 1)); }
            float v[8];
#pragma unroll
            for (int j = 0; j < 8; ++j) v[j] = w_in[(size_t)(kg * 8 + j) * NPROJ + src];
            *(u32x4*)(WinT + (size_t)n * 1024 + kg * 8) = (u32x4){pk_bf16(v[0], v[1]), pk_bf16(v[2], v[3]), pk_bf16(v[4], v[5]), pk_bf16(v[6], v[7])};
        }
    }
    {
        float* rope = (float*)(ws + WS_ROPE);
        for (size_t i = gtid; i < (size_t)4096 * 32; i += gsz) {
            const int t = (int)(i >> 5), k = (int)(i & 31);
            const float inv_freq = powf(10000.0f, -(float)k / 32.0f);
            const float ang = (float)t * inv_freq;
            double sn, cn; sincos((double)ang, &sn, &cn);
            *(f32x2*)(rope + i * 2) = (f32x2){(float)cn, (float)sn};
        }
    }
}

__device__ __forceinline__ void phase_prologue_b(LAS unsigned char* lds, const Args& args, int sb, int nsb) {
    int tid = threadIdx.x; asm volatile("" : "+v"(tid));
    unsigned char* ws = args.ws;
    const size_t gtid = (size_t)sb * NT + tid, gsz = (size_t)nsb * NT;
    {
        const SsmIn SI{args.in[3], args.in[4], args.in[5], args.in[6], args.in[7], args.in[8], args.in[9], args.in[10]};
        for (int u = sb; u < 128; u += nsb) ssm_tables(lds, SI, (float*)(ws + WS_LAM), (bf16_t*)(ws + WS_WS), (bf16_t*)(ws + WS_TW), u >> 2, u & 3);
    }
    {
        const float* w_glu = args.in[11]; bf16_t* WgluT = (bf16_t*)(ws + WS_WGLUT);
        for (size_t i = gtid; i < (size_t)512 * 64; i += gsz) {
            const int n = (int)(i & 511), kg = (int)(i >> 9);
            float v[8];
#pragma unroll
            for (int j = 0; j < 8; ++j) v[j] = w_glu[(size_t)(kg * 8 + j) * 512 + n];
            *(u32x4*)(WgluT + (size_t)n * 512 + kg * 8) = (u32x4){pk_bf16(v[0], v[1]), pk_bf16(v[2], v[3]), pk_bf16(v[4], v[5]), pk_bf16(v[6], v[7])};
        }
    }
    {
        const float* w_out = args.in[15]; const float* g_attn = args.in[13]; const float* g_ssm = args.in[14]; bf16_t* WoutT = (bf16_t*)(ws + WS_WOUTT);
        for (size_t i = gtid; i < (size_t)1024 * 128; i += gsz) {
            const int n = (int)(i & 1023), kg = (int)(i >> 10);
            float v[8];
#pragma unroll
            for (int j = 0; j < 8; ++j) { const int k = kg * 8 + j; const float gn = k < 512 ? g_attn[k] : g_ssm[k - 512]; v[j] = w_out[(size_t)k * 1024 + n] * gn; }
            *(u32x4*)(WoutT + (size_t)n * 1024 + kg * 8) = (u32x4){pk_bf16(v[0], v[1]), pk_bf16(v[2], v[3]), pk_bf16(v[4], v[5]), pk_bf16(v[6], v[7])};
        }
    }
}

constexpr int VROWB = 136;
struct AttnP { const bf16_t *Q, *Kk, *VT, *Za; const float* sink; bf16_t* Ya; float* ssqA; };
__device__ __forceinline__ void attn_item(LAS unsigned char* lds, const AttnP P, int it) {
    int tid = threadIdx.x; asm volatile("" : "+v"(tid));
    const int lane = tid & 63, hd = __builtin_amdgcn_readfirstlane(tid >> 6), kvh = hd >> 2, r32 = lane & 31, h = lane >> 5;
    const int b = it >> 6, q0 = (it & 63) * 64;
    const size_t row0 = (size_t)b * 4096 + q0;
    bf16x8 qf[2][4];
#pragma unroll
    for (int nq = 0; nq < 2; ++nq)
#pragma unroll
        for (int s = 0; s < 4; ++s) qf[nq][s] = *(const bf16x8*)(P.Q + (row0 + nq * 32 + r32) * 512 + hd * 64 + s * 16 + h * 8);
    const float sink2 = P.sink[hd] * LOG2E;
    float mrun[2] = {sink2, sink2}, lrun[2] = {1.f, 1.f};
    f32x16 O[2][2];
#pragma unroll
    for (int i = 0; i < 2; ++i)
#pragma unroll
        for (int j = 0; j < 2; ++j)
#pragma unroll
            for (int r = 0; r < 16; ++r) O[i][j][r] = 0.f;
    LAS unsigned char* Ks = lds;
    LAS unsigned char* Vs = lds + 2 * 64 * ROWB;
    const int kb_lo = (q0 >= 128) ? -2 : -(q0 >> 6), kb_hi = (q0 + 128 <= 4032) ? 2 : ((4032 - q0) >> 6);
    u32x4 pk[2], pv[2];
#define AT_LOAD(kb_) do { const int _ks = q0 + (kb_) * 64; \
        _Pragma("unroll") for (int i = 0; i < 2; ++i) { const int c = tid + i * NT; \
            pk[i] = *(const u32x4*)(P.Kk + ((size_t)b * 4096 + _ks + (c >> 4)) * 128 + (c & 15) * 8); \
            pv[i] = *(const u32x4*)(P.VT + ((size_t)(b * 128 + (c >> 3))) * 4096 + _ks + (c & 7) * 8); } } while (0)
    AT_LOAD(kb_lo);
    for (int kb = kb_lo; kb <= kb_hi; ++kb) {
        __syncthreads();
#pragma unroll
        for (int i = 0; i < 2; ++i) {
            const int c = tid + i * NT, key = c >> 4, part = c & 15;
            *(LAS u32x4*)(Ks + ((part >> 3) * 64 + key) * ROWB + (part & 7) * 16) = pk[i];
            const int rowv = c >> 3, c8 = c & 7;
            *(LAS u32x2*)(Vs + rowv * VROWB + c8 * 16) = (u32x2){pv[i].x, pv[i].y};
            *(LAS u32x2*)(Vs + rowv * VROWB + c8 * 16 + 8) = (u32x2){pv[i].z, pv[i].w};
        }
        __syncthreads();
        if (kb < kb_hi) AT_LOAD(kb + 1);
#pragma unroll
        for (int nq = 0; nq < 2; ++nq) {
            f32x16 S[2];
#pragma unroll
            for (int r = 0; r < 16; ++r) { S[0][r] = 0.f; S[1][r] = 0.f; }
#pragma unroll
            for (int s = 0; s < 4; ++s) {
                const bf16x8 k0 = *(const LAS bf16x8*)(Ks + (kvh * 64 + r32) * ROWB + s * 32 + h * 16);
                const bf16x8 k1 = *(const LAS bf16x8*)(Ks + (kvh * 64 + 32 + r32) * ROWB + s * 32 + h * 16);
                S[0] = MFMA32(k0, qf[nq][s], S[0]);
                S[1] = MFMA32(k1, qf[nq][s], S[1]);
            }
            if (kb == -2 || kb == 2) {
                int base = nq * 32 + r32 - 4 * h;
                asm volatile("" : "+v"(base));
#pragma unroll
                for (int kg = 0; kg < 2; ++kg)
#pragma unroll
                    for (int r = 0; r < 16; ++r) {
                        const int kk = kg * 32 + (r & 3) + 8 * (r >> 2);
                        const bool ok = (kb == -2) ? (kk >= base) : (kk <= base);
                        S[kg][r] = ok ? S[kg][r] : -1e30f;
                    }
            }
            float mx = S[0][0];
#pragma unroll
            for (int r = 1; r < 16; ++r) mx = fmaxf(mx, S[0][r]);
#pragma unroll
            for (int r = 0; r < 16; ++r) mx = fmaxf(mx, S[1][r]);
            mx = fmaxf(mx, __shfl_xor(mx, 32));
            const float mnew = fmaxf(mrun[nq], mx);
            const float alpha = fast_exp2(mrun[nq] - mnew);
            float rs = 0.f;
#pragma unroll
            for (int kg = 0; kg < 2; ++kg)
#pragma unroll
                for (int r = 0; r < 16; ++r) { const float p = fast_exp2(S[kg][r] - mnew); S[kg][r] = p; rs += p; }
            rs += __shfl_xor(rs, 32);
            lrun[nq] = lrun[nq] * alpha + rs; mrun[nq] = mnew;
#pragma unroll
            for (int dg = 0; dg < 2; ++dg)
#pragma unroll
                for (int r = 0; r < 16; ++r) O[dg][nq][r] *= alpha;
#pragma unroll
            for (int kg = 0; kg < 2; ++kg)
#pragma unroll
                for (int s2 = 0; s2 < 2; ++s2) {
                    const u32x4 w = (u32x4){pk_bf16(S[kg][8 * s2], S[kg][8 * s2 + 1]), pk_bf16(S[kg][8 * s2 + 2], S[kg][8 * s2 + 3]),
                                            pk_bf16(S[kg][8 * s2 + 4], S[kg][8 * s2 + 5]), pk_bf16(S[kg][8 * s2 + 6], S[kg][8 * s2 + 7])};
                    const bf16x8 pf = __builtin_bit_cast(bf16x8, w);
#pragma unroll
                    for (int dg = 0; dg < 2; ++dg) {
                        const LAS unsigned char* vb = Vs + (kvh * 64 + dg * 32 + r32) * VROWB + (kg * 32 + s2 * 16 + 4 * h) * 2;
                        const u32x2 lo = *(const LAS u32x2*)vb, hi = *(const LAS u32x2*)(vb + 16);
                        const bf16x8 vf = __builtin_bit_cast(bf16x8, ((u32x4){lo.x, lo.y, hi.x, hi.y}));
                        O[dg][nq] = MFMA32(vf, pf, O[dg][nq]);
                    }
                }
        }
    }
#pragma unroll
    for (int nq = 0; nq < 2; ++nq) {
        const size_t row = row0 + nq * 32 + r32;
        const float inv = 1.0f / lrun[nq];
        float ssq = 0.f;
#pragma unroll
        for (int dg = 0; dg < 2; ++dg)
#pragma unroll
            for (int q = 0; q < 4; ++q) {
                const int d = hd * 64 + dg * 32 + q * 8 + h * 4;
                const u32x2 zw = *(const u32x2*)(P.Za + row * 512 + d);
                const float y0 = O[dg][nq][4 * q] * inv * siluf_(bf_lo(zw.x)), y1 = O[dg][nq][4 * q + 1] * inv * siluf_(bf_hi(zw.x));
                const float y2 = O[dg][nq][4 * q + 2] * inv * siluf_(bf_lo(zw.y)), y3 = O[dg][nq][4 * q + 3] * inv * siluf_(bf_hi(zw.y));
                ssq += (y0 * y0 + y1 * y1) + (y2 * y2 + y3 * y3);
                u32x2 w; w.x = pk_bf16(y0, y1); w.y = pk_bf16(y2, y3);
                *(u32x2*)(P.Ya + row * 512 + d) = w;
            }
        ssq += __shfl_xor(ssq, 32);
        if (h == 0) P.ssqA[row * 8 + hd] = ssq;
    }
}

#ifndef G8_SP2
#define G8_SP2 true
#endif
constexpr int NPHASE = 6;
#ifndef REP0
#define REP0 1
#endif
#ifndef REP1
#define REP1 1
#endif
#ifndef REP2
#define REP2 1
#endif
#ifndef REP3
#define REP3 1
#endif
#ifndef REP4
#define REP4 1
#endif
#ifndef REP5
#define REP5 1
#endif
#ifndef REP6
#define REP6 1
#endif
__global__ void __launch_bounds__(NT) fwd_kernel(Args args) {
    extern __shared__ __attribute__((aligned(16))) unsigned char lds_raw[];
    LAS unsigned char* lds = (LAS unsigned char*)lds_raw;
    const int tid = threadIdx.x;
    unsigned char* ws = args.ws;
    volatile LAS unsigned* st = (volatile LAS unsigned*)(lds + LDS_MAIN2);
    if (tid < 16) st[tid] = 0u;
    __syncthreads();
    const int lo = args.ph_lo, hi = args.ph_hi;
    XcdBarrier bar; bar.bar = (unsigned*)(ws + WS_BAR); bar.x = 0; bar.st = st;
    if (hi - lo > 1) bar = xcd_barrier_post((unsigned*)(ws + WS_BAR), st);
    if (args.never) cg::this_grid().sync();
#ifndef ONLY
#define ONLY -1
#endif
#ifndef PHMASK
#define PHMASK 255
#endif
#define IN(k) (((PHMASK >> (k)) & 1) && (ONLY < 0 || ONLY == (k)) && lo <= (k) && (k) < hi)
#define SEAM(k) do { if (IN(k) && IN((k) + 1)) xcd_barrier(bar); } while (0)
    const int G = gridDim.x, bx = (gridDim.x % 8 == 0) ? (int)((blockIdx.x % 8) * (gridDim.x / 8) + blockIdx.x / 8) : (int)blockIdx.x;

    if (IN(0)) for (int rep = 0; rep < REP0; ++rep) phase_prologue(lds, args);
    SEAM(0);
    const bool fast = false;
    unsigned* evt = (unsigned*)(ws + WS_BAR) + 64;
    if (IN(1)) {
        const bf16_t* Xb = (const bf16_t*)(ws + WS_XB); const bf16_t* WinT = (const bf16_t*)(ws + WS_WINT);
        EpiProj8 E8{(bf16_t*)(ws + WS_Q), (bf16_t*)(ws + WS_K), (bf16_t*)(ws + WS_VT), (bf16_t*)(ws + WS_ZA), (bf16_t*)(ws + WS_UG), (bf16_t*)(ws + WS_ZS), (const float*)(ws + WS_ROPE)};
#pragma clang loop unroll(disable)
        for (int stage = 0; stage < (fast ? 2 : 1); ++stage) {
            const SchedP1 SP{bx, G, fast ? stage + 1 : 0};
            gemm8_phase<EpiProj8, SchedP1, false, false, G8_SP2>(lds, Xb, Xb, 1024, 1 << 20, WinT, 1024, 16, SP, E8);
            if (stage == 0) {
                if (fast) { if (bx >= 64) phase_prologue_b(lds, args, bx - 64, 192); }
                else { int ntile = 0; for (int t_ = bx; t_ < 576; t_ += G) ++ntile; const int nr = (576 + G - 1) / G;
                    if (ntile < nr || G >= 576) { int nshort = nr * G - 576, first = G - nshort; if (nshort <= 0 || nshort > G) { nshort = G; first = 0; } if (bx >= first) phase_prologue_b(lds, args, bx - first, nshort); } }
                if (fast) {
                    asm volatile("s_waitcnt vmcnt(0)" ::: "memory");
                    __syncthreads();
                    if (tid == 0) { __builtin_amdgcn_fence(__ATOMIC_RELEASE, "agent"); asm volatile("s_waitcnt vmcnt(0)" ::: "memory"); (void)xb_add(evt, 1u); }
                }
            }
        }
    }
    if (fast) {
        if (tid == 0) { XB_SPIN(xb_ld(evt) < 256u, (unsigned*)(ws + WS_BAR)); __builtin_amdgcn_fence(__ATOMIC_ACQUIRE, "agent"); asm volatile("s_waitcnt vmcnt(0)" ::: "memory"); }
        __syncthreads();
    } else SEAM(1);
    if (IN(2)) {
        const AttnP AP{(const bf16_t*)(ws + WS_Q), (const bf16_t*)(ws + WS_K), (const bf16_t*)(ws + WS_VT), (const bf16_t*)(ws + WS_ZA), args.in[2], (bf16_t*)(ws + WS_YA), (float*)(ws + WS_SSQA)};
        int a0 = bx, as_ = G, an = (256 - bx + G - 1) / G, t0 = bx, ts = G, tn = (256 - bx + G - 1) / G;
        if (bx >= 256) { an = 0; tn = 0; }
        if (fast) { const int wi = bx - 64; a0 = wi; as_ = 192; an = wi < 0 ? 0 : (wi < 64 ? 2 : 1); t0 = 2 * (wi - 64); ts = 1; tn = wi >= 64 ? 2 : 0; }
#pragma clang loop unroll(disable)
        for (int k = 0; k < an; ++k) attn_item(lds, AP, a0 + k * as_);
        __syncthreads();
#pragma clang loop unroll(disable)
        for (int k = 0; k < tn; ++k) { const int t = t0 + k * ts; const int g = t >> 3, mt = (t >> 1) & 3, nt_ = t & 1;
            EpiSScan E{lds, (const float*)(ws + WS_LAM), (bf16_t*)(ws + WS_XIN), g, mt, nt_};
            const bf16_t* A = (const bf16_t*)(ws + WS_UG) + (size_t)g * 16384 * 16;
            gemm_tile<EpiSScan, false>(lds, A, 256, A, 256, 1 << 30, (const bf16_t*)(ws + WS_WS) + (size_t)g * 256 * 256, 256, 256, mt * BM, nt_ * BN, E); }
    }
    SEAM(2);
    if (IN(3)) {
        for (int t_ = bx; t_ < 256 * REP4; t_ += G) { const int t = t_ & 255; const int g = t >> 3, mt = (t >> 1) & 3, nt_ = t & 1;
            EpiY E{(bf16_t*)(ws + WS_G), g};
            gemm_tile<EpiY, false>(lds, (const bf16_t*)(ws + WS_UG) + (size_t)g * 16384 * 16, 256, (const bf16_t*)(ws + WS_XIN) + (size_t)g * 1024 * 256, 256, 256, (const bf16_t*)(ws + WS_TW) + (size_t)g * 256 * 512, 512, 512, mt * BM, nt_ * BN, E); }
    }
    SEAM(3);
    if (IN(4)) {
        EpiGlu E{(const bf16_t*)(ws + WS_G), (const bf16_t*)(ws + WS_ZS), args.in[12], (bf16_t*)(ws + WS_YS), (float*)(ws + WS_SSQS)};
        const bf16_t* Gp = (const bf16_t*)(ws + WS_G); const bf16_t* WgluT = (const bf16_t*)(ws + WS_WGLUT);
        for (int t_ = bx; t_ < 64 * 4 * REP5; t_ += G) { const int t = t_ & 255; const int mt = t >> 2, nt_ = t & 3;
            gemm_tile<EpiGlu, false>(lds, Gp, 512, Gp, 512, 1 << 30, WgluT, 512, 512, mt * BM, nt_ * BN, E); }
    }
    SEAM(4);
    if (IN(5)) {
        const bf16_t* Ya = (const bf16_t*)(ws + WS_YA); const bf16_t* Ys = (const bf16_t*)(ws + WS_YS); const bf16_t* WoutT = (const bf16_t*)(ws + WS_WOUTT);
        if (bx < 256) { const int mt = bx >> 2;
            EpiOut8 E{lds, args.in[0], (const float*)(ws + WS_SSQA), (const float*)(ws + WS_SSQS), args.in[16], args.in[17], args.out, (unsigned long long*)(ws + WS_LNST),
                      (unsigned*)(ws + WS_CNT) + mt * 64, 32u};
            const SchedOut SO{bx};
            gemm8_phase<EpiOut8, SchedOut, true, true, G8_SP2>(lds, Ya, Ys, 512, 8, WoutT, 1024, 16, SO, E); }
    }
#undef IN
#undef SEAM
}

extern "C" void kernel_launch(void* const* d_in, const int* in_sizes, int n_in, void* d_out, int out_size, void* d_ws, size_t ws_size, hipStream_t stream) {
    static int grid = 0;
    if (grid == 0) {
        if (n_in != 18 || ws_size < WS_END) { fprintf(stderr, "kernel_launch: unexpected inputs (n_in %d, ws %zu, need %zu)\n", n_in, ws_size, (size_t)WS_END); grid = -1; return; }
        int dev = 0, cus = 0, per_cu = 0;
        hipGetDevice(&dev);
        hipDeviceGetAttribute(&cus, hipDeviceAttributeMultiprocessorCount, dev);
        if (hipFuncSetAttribute((const void*)fwd_kernel, hipFuncAttributeMaxDynamicSharedMemorySize, LDS_BYTES) != hipSuccess) { fprintf(stderr, "kernel_launch: hipFuncSetAttribute failed\n"); grid = -1; return; }
        if (hipOccupancyMaxActiveBlocksPerMultiprocessor(&per_cu, (const void*)fwd_kernel, NT, LDS_BYTES) != hipSuccess || per_cu < 1) { fprintf(stderr, "kernel_launch: occupancy query says %d\n", per_cu); per_cu = 1; }
        (void)hipGetLastError();
        grid = cus;
    }
    if (grid < 0) return;
    (void)hipMemsetAsync((char*)d_ws + WS_BAR, 0, 32768, stream);
    Args a{};
    for (int i = 0; i < 18; ++i) a.in[i] = (const float*)d_in[i];
    a.out = (float*)d_out; a.ws = (unsigned char*)d_ws; a.never = 0; a.pad = 0;
#if N_LAUNCH_MODE == 1
    for (int ph = 0; ph < NPHASE; ++ph) {
        a.ph_lo = ph; a.ph_hi = ph + 1;
        hipLaunchKernelGGL(fwd_kernel, dim3(grid), dim3(NT), LDS_BYTES, stream, a);
    }
#else
    a.ph_lo = 0; a.ph_hi = NPHASE;
    void* kargs[] = {&a};
    hipError_t e = hipLaunchCooperativeKernel((const void*)fwd_kernel, dim3(grid), dim3(NT), kargs, LDS_BYTES, stream);
    if (e != hipSuccess) fprintf(stderr, "kernel_launch: cooperative launch failed: %s (grid %d)\n", hipGetErrorString(e), grid);
#endif
}
```

```cpp
#include <hip/hip_runtime.h>
#include <hip/hip_cooperative_groups.h>
#include <cstdint>
#include <cstdio>
namespace cg = cooperative_groups;

#ifndef N_LAUNCH_MODE
#define N_LAUNCH_MODE 0
#endif

typedef unsigned short bf16_t;
typedef short bf16x8 __attribute__((ext_vector_type(8)));
typedef float f32x16 __attribute__((ext_vector_type(16)));
typedef float f32x4 __attribute__((ext_vector_type(4)));
typedef float f32x2 __attribute__((ext_vector_type(2)));
typedef unsigned u32x4 __attribute__((ext_vector_type(4)));
typedef unsigned u32x2 __attribute__((ext_vector_type(2)));
#define LAS __attribute__((address_space(3)))

constexpr int NT = 512;
constexpr int SEQ = 4096, DM = 1024, MTOK = 16384, NPROJ = 2304;
constexpr float LOG2E = 1.4426950408889634f;
constexpr float QSCALE = 0.125f * LOG2E;
constexpr float NORM_EPS = 1e-5f;
constexpr float DN_ALPHA = 1.189207115002721f;

constexpr size_t WS_BAR = 0;
constexpr size_t WS_CNT = 16384;
constexpr size_t WS_WINT = 32768;
constexpr size_t WS_WGLUT = WS_WINT + (size_t)2304 * 1024 * 2;
constexpr size_t WS_WOUTT = WS_WGLUT + (size_t)512 * 512 * 2;
constexpr size_t WS_ROPE = WS_WOUTT + (size_t)1024 * 1024 * 2;
constexpr size_t WS_LAM = WS_ROPE + (size_t)4096 * 32 * 8;
constexpr size_t WS_WS = WS_LAM + 65536;
constexpr size_t WS_TW = WS_WS + (size_t)32 * 256 * 256 * 2;
constexpr size_t WS_XB = WS_TW + (size_t)32 * 256 * 512 * 2;
constexpr size_t WS_S = WS_XB;
constexpr size_t WS_Q = WS_XB + (size_t)16384 * 1024 * 2;
constexpr size_t WS_K = WS_Q + (size_t)16384 * 512 * 2;
constexpr size_t WS_VT = WS_K + (size_t)16384 * 128 * 2;
constexpr size_t WS_ZA = WS_VT + (size_t)16384 * 128 * 2;
constexpr size_t WS_UG = WS_ZA + (size_t)16384 * 512 * 2;
constexpr size_t WS_ZS = WS_UG + (size_t)16384 * 512 * 2;
constexpr size_t WS_XIN = WS_ZS + (size_t)16384 * 512 * 2;
constexpr size_t WS_G = WS_XIN + (size_t)32 * 1024 * 256 * 2;
constexpr size_t WS_YA = WS_G + (size_t)16384 * 512 * 2;
constexpr size_t WS_YS = WS_YA + (size_t)16384 * 512 * 2;
constexpr size_t WS_SSQA = WS_YS + (size_t)16384 * 512 * 2;
constexpr size_t WS_SSQS = WS_SSQA + (size_t)16384 * 8 * 4;
constexpr size_t WS_LNST = WS_SSQS + (size_t)16384 * 8 * 4;
constexpr size_t WS_END = WS_LNST + (size_t)16384 * 16 * 2 * 4;

__device__ __forceinline__ unsigned pk_bf16(float lo, float hi) { unsigned r; asm("v_cvt_pk_bf16_f32 %0, %1, %2" : "=v"(r) : "v"(lo), "v"(hi)); return r; }
__device__ __forceinline__ bf16_t to_bf16(float v) { return (bf16_t)(pk_bf16(v, 0.f) & 0xffffu); }
__device__ __forceinline__ float bf_lo(unsigned w) { return __uint_as_float(w << 16); }
__device__ __forceinline__ float bf_hi(unsigned w) { return __uint_as_float(w & 0xffff0000u); }
__device__ __forceinline__ float fast_exp2(float x) { return __builtin_amdgcn_exp2f(x); }
__device__ __forceinline__ float sigmoidf_(float x) { return __builtin_amdgcn_rcpf(1.0f + __builtin_amdgcn_exp2f(-1.4426950408889634f * x)); }
__device__ __forceinline__ float siluf_(float x) { return x * sigmoidf_(x); }
__device__ __forceinline__ float gelu_tanh(float x) {
    const float z2 = 1.5957691216057308f * (x + 0.044715f * x * x * x);
    return x * __builtin_amdgcn_rcpf(1.0f + __builtin_amdgcn_exp2f(-1.4426950408889634f * z2));
}
#define MFMA32(a, b, c) __builtin_amdgcn_mfma_f32_32x32x16_bf16((a), (b), (c), 0, 0, 0)

#define XB_TMO      128
#define XB_XCNT(j)  (256  + 64 * (j))
#define XB_XSUB(j)  (1280 + 64 * (j))
#define XB_XGEN(j)  (2304 + 64 * (j))
#define XB_TOP      3328
#define XB_TOPGEN   3392
#define XCD_BAR_WORDS 3456
#define XB_SPIN_CAP (1u << 22)
__device__ __forceinline__ unsigned xb_ld(unsigned* p)              { return __hip_atomic_load(p, __ATOMIC_RELAXED, __HIP_MEMORY_SCOPE_AGENT); }
__device__ __forceinline__ unsigned xb_add(unsigned* p, unsigned v) { return __hip_atomic_fetch_add(p, v, __ATOMIC_RELAXED, __HIP_MEMORY_SCOPE_AGENT); }
__device__ __forceinline__ unsigned xb_xcc_id() { return (unsigned)__builtin_amdgcn_s_getreg((3 << 11) | 20) & 0xFu; }
#define XB_SPIN(cond, bar) do { unsigned _sp = 0; while (cond) { __builtin_amdgcn_s_sleep(1); \
    if ((++_sp & 255u) == 0u) { if (xb_ld(&(bar)[XB_TMO])) break; if (_sp > XB_SPIN_CAP) { atomicAdd(&(bar)[XB_TMO], 1u); break; } } } } while (0)
struct XcdBarrier { unsigned* bar; unsigned x; volatile LAS unsigned* st; };
__device__ __forceinline__ XcdBarrier xcd_barrier_post(unsigned* bar, volatile LAS unsigned* st) {
    XcdBarrier b; b.bar = bar; b.x = xb_xcc_id(); b.st = st;
    if (threadIdx.x == 0) (void)xb_add(&bar[XB_XCNT(b.x)], 1u);
    return b;
}
__device__ __forceinline__ void xcd_barrier_complete(unsigned* bar, unsigned x, unsigned& nloc, unsigned& nx) {
    const unsigned G = gridDim.x * gridDim.y * gridDim.z;
    unsigned sum, cnt, mine, sp = 0u;
    for (;;) {
        sum = 0u; cnt = 0u; mine = 0u;
#pragma unroll
        for (unsigned j = 0; j < 16; ++j) { const unsigned c = xb_ld(&bar[XB_XCNT(j)]); sum += c; cnt += (c > 0u) ? 1u : 0u; mine = (j == x) ? c : mine; }
        if (sum == G) break;
        __builtin_amdgcn_s_sleep(1);
        if ((++sp & 255u) == 0u) { if (xb_ld(&bar[XB_TMO])) break; if (sp > XB_SPIN_CAP) { atomicAdd(&bar[XB_TMO], 1u); break; } }
    }
    nloc = mine > 0u ? mine : 1u; nx = cnt > 0u ? cnt : 1u;
}
__device__ __forceinline__ void xcd_barrier(const XcdBarrier& b) {
    asm volatile("s_waitcnt vmcnt(0)" ::: "memory");
    __syncthreads();
    if (threadIdx.x == 0) {
        unsigned* bar = b.bar;
        __builtin_amdgcn_s_waitcnt(0);
        unsigned nloc = b.st[0], nx = b.st[1];
        if (nloc == 0u) { xcd_barrier_complete(bar, b.x, nloc, nx); b.st[0] = nloc; b.st[1] = nx; }
        const unsigned old = xb_add(&bar[XB_XSUB(b.x)], 1u);
        const unsigned gen = old / nloc;
        if (old + 1u == (gen + 1u) * nloc) {
            __builtin_amdgcn_fence(__ATOMIC_RELEASE, "agent");
            asm volatile("s_waitcnt vmcnt(0)" ::: "memory");
            const unsigned og = xb_add(&bar[XB_TOP], 1u);
            const unsigned tg = og / nx;
            if (og + 1u == (tg + 1u) * nx) xb_add(&bar[XB_TOPGEN], 1u);
            else XB_SPIN(xb_ld(&bar[XB_TOPGEN]) == tg, bar);
            __builtin_amdgcn_fence(__ATOMIC_ACQUIRE, "agent");
            xb_add(&bar[XB_XGEN(b.x)], 1u);
            asm volatile("s_waitcnt vmcnt(0)" ::: "memory");
        } else {
            XB_SPIN(xb_ld(&bar[XB_XGEN(b.x)]) == gen, bar);
            __builtin_amdgcn_fence(__ATOMIC_ACQUIRE, "agent");
            asm volatile("s_waitcnt vmcnt(0)" ::: "memory");
        }
    }
    __syncthreads();
}

struct Args { const float* in[18]; float* out; unsigned char* ws; int ph_lo, ph_hi, never, pad; };

constexpr int BM = 256, BN = 128, BK = 64;
constexpr int ROWB = 144;
constexpr int A_STAGE = BM * 128, B_STAGE = BN * 128, STAGE = A_STAGE + B_STAGE;
constexpr int LDS_MAIN = 3 * STAGE;
constexpr int SLDS_ROW = 528;
constexpr int LDS_SCAN_E = 256 * SLDS_ROW;
constexpr int LDS_MAIN2 = LDS_MAIN > (LDS_SCAN_E + 4096) ? LDS_MAIN : (LDS_SCAN_E + 4096);
constexpr int LDS_BYTES = LDS_MAIN2 + 64;

template <class Epi, bool MID>
__device__ __forceinline__ void gemm_tile(LAS unsigned char* lds, const bf16_t* __restrict__ A0, int lda0, const bf16_t* __restrict__ A1, int lda1, int ksplit,
                                          const bf16_t* __restrict__ Bt, int ldb, int K, int m0, int n0, const Epi& epi) {
    int tid = threadIdx.x; asm volatile("" : "+v"(tid));
    const int lane = tid & 63, wid = __builtin_amdgcn_readfirstlane(tid >> 6);
    const int wm = wid >> 1, wn = wid & 1, r32 = lane & 31, h = lane >> 5;
    const int grow = lane >> 3, gc = lane & 7;
    const int csrc = (gc ^ (((wid * 8 + grow) >> 1) & 7)) * 8;
    const int rs_ = (wid * 8 + grow) & 31, rperm = 16 * ((rs_ >> 2) & 1) + 4 * (rs_ >> 3) + (rs_ & 3);
    const size_t arow = (size_t)(m0 + wid * 8 + grow), brow = (size_t)(n0 + ((wid * 8 + grow) & ~31) + rperm);
    f32x16 acc[2][2];
#pragma unroll
    for (int i = 0; i < 2; ++i)
#pragma unroll
        for (int j = 0; j < 2; ++j)
#pragma unroll
            for (int r = 0; r < 16; ++r) acc[i][j][r] = 0.f;
    const int nt = K / BK;
#define GT_STAGE(kt, buf) do { const int _k0 = (kt) * BK; const bf16_t* _ab; int _ld, _kk; \
        if (_k0 < ksplit) { _ab = A0; _ld = lda0; _kk = _k0; } else { _ab = A1; _ld = lda1; _kk = _k0 - ksplit; } \
        const bf16_t* _ga = _ab + arow * _ld + _kk + csrc; const bf16_t* _gb = Bt + brow * ldb + _k0 + csrc; \
        LAS unsigned char* _la = lds + (buf) * STAGE + wid * 1024; \
        _Pragma("unroll") for (int _i = 0; _i < 4; ++_i) __builtin_amdgcn_global_load_lds((const unsigned*)(_ga + (size_t)_i * 64 * _ld), (LAS unsigned*)(_la + _i * 8192), 16, 0, 0); \
        _Pragma("unroll") for (int _i = 0; _i < 2; ++_i) __builtin_amdgcn_global_load_lds((const unsigned*)(_gb + (size_t)_i * 64 * ldb), (LAS unsigned*)(_la + A_STAGE + _i * 8192), 16, 0, 0); } while (0)
    const int swz = (r32 >> 1) & 7;
    const int o0 = ((0 + h) ^ swz) << 4, o1 = ((2 + h) ^ swz) << 4, o2 = ((4 + h) ^ swz) << 4, o3 = ((6 + h) ^ swz) << 4;
    int bcur = 0, bnxt = STAGE, bnn = 2 * STAGE;
    GT_STAGE(0, 0);
    if (nt > 1) GT_STAGE(1, 1);
    for (int kt = 0; kt < nt; ++kt) {
        if (kt + 1 < nt) asm volatile("s_waitcnt vmcnt(6)" ::: "memory"); else asm volatile("s_waitcnt vmcnt(0)" ::: "memory");
        __builtin_amdgcn_s_barrier();
        asm volatile("" ::: "memory");
        const bool st = (kt + 2 < nt);
        const bf16_t* _ga; const bf16_t* _gb; int _ld = lda0;
        {
            const int _k0 = (kt + 2) * BK; const bf16_t* _ab; int _kk;
            if (_k0 < ksplit) { _ab = A0; _ld = lda0; _kk = _k0; } else { _ab = A1; _ld = lda1; _kk = _k0 - ksplit; }
            _ga = _ab + arow * _ld + _kk + csrc; _gb = Bt + brow * ldb + _k0 + csrc;
        }
        LAS unsigned char* _la = lds + bnn + wid * 1024;
        if constexpr (MID) { if (kt * BK == ksplit) epi.mid(acc, m0 + wm * 64 + r32); }
        const LAS unsigned char* sa = lds + bcur + (wm * 64 + r32) * 128;
        const LAS unsigned char* sb = lds + bcur + A_STAGE + (wn * 64 + r32) * 128;
#define GT_LD(A0_, A1_, B0_, B1_, off) do { A0_ = *(const LAS bf16x8*)(sa + (off)); A1_ = *(const LAS bf16x8*)(sa + 32 * 128 + (off)); \
            B0_ = *(const LAS bf16x8*)(sb + (off)); B1_ = *(const LAS bf16x8*)(sb + 32 * 128 + (off)); } while (0)
#define GT_MM(A0_, A1_, B0_, B1_) do { acc[0][0] = MFMA32(B0_, A0_, acc[0][0]); acc[0][1] = MFMA32(B1_, A0_, acc[0][1]); \
            acc[1][0] = MFMA32(B0_, A1_, acc[1][0]); acc[1][1] = MFMA32(B1_, A1_, acc[1][1]); } while (0)
        bf16x8 xa0, xa1, xb0, xb1, ya0, ya1, yb0, yb1;
        GT_LD(xa0, xa1, xb0, xb1, o0);
        GT_LD(ya0, ya1, yb0, yb1, o1);
        GT_MM(xa0, xa1, xb0, xb1);
        __builtin_amdgcn_sched_barrier(0);
        if (st) { __builtin_amdgcn_global_load_lds((const unsigned*)(_ga), (LAS unsigned*)(_la), 16, 0, 0);
                  __builtin_amdgcn_global_load_lds((const unsigned*)(_ga + (size_t)64 * _ld), (LAS unsigned*)(_la + 8192), 16, 0, 0); }
        GT_LD(xa0, xa1, xb0, xb1, o2);
        __builtin_amdgcn_sched_barrier(0);
        GT_MM(ya0, ya1, yb0, yb1);
        __builtin_amdgcn_sched_barrier(0);
        if (st) { __builtin_amdgcn_global_load_lds((const unsigned*)(_ga + (size_t)128 * _ld), (LAS unsigned*)(_la + 2 * 8192), 16, 0, 0);
                  __builtin_amdgcn_global_load_lds((const unsigned*)(_ga + (size_t)192 * _ld), (LAS unsigned*)(_la + 3 * 8192), 16, 0, 0); }
        GT_LD(ya0, ya1, yb0, yb1, o3);
        __builtin_amdgcn_sched_barrier(0);
        GT_MM(xa0, xa1, xb0, xb1);
        __builtin_amdgcn_sched_barrier(0);
        if (st) { __builtin_amdgcn_global_load_lds((const unsigned*)(_gb), (LAS unsigned*)(_la + A_STAGE), 16, 0, 0);
                  __builtin_amdgcn_global_load_lds((const unsigned*)(_gb + (size_t)64 * ldb), (LAS unsigned*)(_la + A_STAGE + 8192), 16, 0, 0); }
        __builtin_amdgcn_sched_barrier(0);
        GT_MM(ya0, ya1, yb0, yb1);
#undef GT_LD
#undef GT_MM
        { const int t_ = bcur; bcur = bnxt; bnxt = bnn; bnn = t_; }
    }
    asm volatile("" ::: "memory");
    __builtin_amdgcn_s_barrier();
    asm volatile("" ::: "memory");
#undef GT_STAGE
    epi.run(acc, m0 + wm * 64, n0 + wn * 64, r32, h);
}

struct EpiProj {
    bf16_t *Q, *Kk, *VT, *Za, *Ug, *Zs; const float* rope;
    __device__ __forceinline__ void run(const f32x16 (&acc)[2][2], int mrow0, int ncol0, int r32, int h) const {
#pragma unroll
        for (int mi = 0; mi < 2; ++mi) {
            const int row = mrow0 + mi * 32 + r32, t = row & 4095;
#pragma unroll
            for (int ni = 0; ni < 2; ++ni) {
#pragma unroll
                for (int q = 0; q < 4; ++q) {
                    const int col = ncol0 + ni * 32 + q * 8 + h * 4;
                    float v0 = acc[mi][ni][4 * q], v1 = acc[mi][ni][4 * q + 1], v2 = acc[mi][ni][4 * q + 2], v3 = acc[mi][ni][4 * q + 3];
                    if (ncol0 < 640) {
                        const int i0 = (col & 63) >> 1;
                        const f32x4 cs = *(const f32x4*)(rope + ((size_t)t * 32 + i0) * 2);
                        float o0 = v0 * cs[0] - v1 * cs[1], o1 = v1 * cs[0] + v0 * cs[1], o2 = v2 * cs[2] - v3 * cs[3], o3 = v3 * cs[2] + v2 * cs[3];
                        if (ncol0 < 512) { u32x2 w; w.x = pk_bf16(o0 * QSCALE, o1 * QSCALE); w.y = pk_bf16(o2 * QSCALE, o3 * QSCALE); *(u32x2*)(Q + (size_t)row * 512 + col) = w; }
                        else { u32x2 w; w.x = pk_bf16(o0, o1); w.y = pk_bf16(o2, o3); *(u32x2*)(Kk + (size_t)row * 128 + (col - 512)) = w; }
                    } else if (ncol0 < 768) {
                        const int c = col - 640, b = row >> 12;
                        bf16_t* p = VT + ((size_t)(b * 128 + c)) * 4096 + t;
                        p[0] = to_bf16(v0); p[4096] = to_bf16(v1); p[8192] = to_bf16(v2); p[12288] = to_bf16(v3);
                    } else {
                        u32x2 w; w.x = pk_bf16(v0, v1); w.y = pk_bf16(v2, v3);
                        if (ncol0 < 1280) *(u32x2*)(Za + (size_t)row * 512 + (col - 768)) = w;
                        else if (ncol0 < 1792) { const int c = col - 1280; *(u32x2*)(Ug + ((size_t)(c >> 4) * 16384 + row) * 16 + (c & 15)) = w; }
                        else *(u32x2*)(Zs + (size_t)row * 512 + (col - 1792)) = w;
                    }
                }
            }
        }
    }
};
struct EpiSScan {
    LAS unsigned char* lds; const float* lam; bf16_t* Xin; int g, b, dir;
    __device__ __forceinline__ void run(const f32x16 (&acc)[2][2], int mrow0, int ncol0, int r32, int h) const {
        const int lrow0 = mrow0 - b * 256, lcol0 = ncol0 - dir * 128;
#pragma unroll
        for (int mi = 0; mi < 2; ++mi) {
            const int row = lrow0 + mi * 32 + r32;
#pragma unroll
            for (int ni = 0; ni < 2; ++ni)
#pragma unroll
                for (int q = 0; q < 4; ++q) {
                    const int col = lcol0 + ni * 32 + 16 * h + 4 * q;
                    *(LAS f32x4*)(lds + row * SLDS_ROW + col * 4) = (f32x4){acc[mi][ni][4 * q], acc[mi][ni][4 * q + 1], acc[mi][ni][4 * q + 2], acc[mi][ni][4 * q + 3]};
                }
        }
        __syncthreads();
        int tid = threadIdx.x; asm volatile("" : "+v"(tid));
        const int seg = __builtin_amdgcn_readfirstlane(tid >> 6), p = tid & 63;
        LAS f32x2* E = (LAS f32x2*)(lds + LDS_SCAN_E);
        const f32x2 lm = *(const f32x2*)(lam + ((size_t)(g * 2 + dir) * 64 + p) * 2);
        const f32x2 lm32 = *(const f32x2*)(lam + 8192 + ((size_t)(g * 2 + dir) * 64 + p) * 2);
        const LAS unsigned char* Sp = lds + p * 8;
        bf16_t* Xp = Xin + ((size_t)g * 1024 + b * 256) * 256 + dir * 128 + 2 * p;
        float er = 0.f, ei = 0.f;
#pragma unroll 8
        for (int i = 0; i < 32; ++i) {
            const int c = dir == 0 ? seg * 32 + i : seg * 32 + 31 - i;
            const f32x2 sv = *(const LAS f32x2*)(Sp + c * SLDS_ROW);
            const float nr = lm.x * er - lm.y * ei + sv.x, ni = lm.x * ei + lm.y * er + sv.y;
            er = nr; ei = ni;
        }
        E[seg * 64 + p] = (f32x2){er, ei};
        __syncthreads();
        float cr = 0.f, ci = 0.f;
        if (dir == 0) { for (int s2 = 0; s2 < seg; ++s2) { const f32x2 e = E[s2 * 64 + p]; const float nr = lm32.x * cr - lm32.y * ci + e.x, ni = lm32.x * ci + lm32.y * cr + e.y; cr = nr; ci = ni; } }
        else { for (int s2 = 7; s2 > seg; --s2) { const f32x2 e = E[s2 * 64 + p]; const float nr = lm32.x * cr - lm32.y * ci + e.x, ni = lm32.x * ci + lm32.y * cr + e.y; cr = nr; ci = ni; } }
#pragma unroll 8
        for (int i = 0; i < 32; ++i) {
            const int c = dir == 0 ? seg * 32 + i : seg * 32 + 31 - i;
            const f32x2 sv = *(const LAS f32x2*)(Sp + c * SLDS_ROW);
            *(unsigned*)(Xp + (size_t)c * 256) = pk_bf16(cr, ci);
            const float nr = lm.x * cr - lm.y * ci + sv.x, ni = lm.x * ci + lm.y * cr + sv.y;
            cr = nr; ci = ni;
        }
        __syncthreads();
    }
};
struct EpiY {
    bf16_t* G; int g;
    __device__ __forceinline__ void run(const f32x16 (&acc)[2][2], int mrow0, int ncol0, int r32, int h) const {
#pragma unroll
        for (int mi = 0; mi < 2; ++mi) {
            const int row = mrow0 + mi * 32 + r32;
#pragma unroll
            for (int ni = 0; ni < 2; ++ni) {
                const int pos = (ncol0 + ni * 32 + 16 * h) >> 4;
                unsigned w[8];
#pragma unroll
                for (int e = 0; e < 8; ++e) w[e] = pk_bf16(gelu_tanh(acc[mi][ni][2 * e]), gelu_tanh(acc[mi][ni][2 * e + 1]));
                bf16_t* p = G + ((size_t)row * 16 + pos) * 512 + g * 16;
                *(u32x4*)p = (u32x4){w[0], w[1], w[2], w[3]}; *(u32x4*)(p + 8) = (u32x4){w[4], w[5], w[6], w[7]};
            }
        }
    }
};
struct EpiGlu {
    const bf16_t *G, *Zs; const float* bglu; bf16_t* Ys; float* ssqS;
    __device__ __forceinline__ void run(const f32x16 (&acc)[2][2], int mrow0, int ncol0, int r32, int h) const {
        f32x4 bq[2][4];
#pragma unroll
        for (int ni = 0; ni < 2; ++ni)
#pragma unroll
            for (int q = 0; q < 4; ++q) bq[ni][q] = *(const f32x4*)(bglu + ncol0 + ni * 32 + 16 * h + 4 * q);
#pragma unroll
        for (int mi = 0; mi < 2; ++mi) {
            const int row = mrow0 + mi * 32 + r32; float ssq = 0.f;
#pragma unroll
            for (int ni = 0; ni < 2; ++ni) {
                const int col = ncol0 + ni * 32 + 16 * h;
                const u32x4 g0 = *(const u32x4*)(G + (size_t)row * 512 + col), g1 = *(const u32x4*)(G + (size_t)row * 512 + col + 8);
                const u32x4 z0 = *(const u32x4*)(Zs + (size_t)row * 512 + col), z1 = *(const u32x4*)(Zs + (size_t)row * 512 + col + 8);
                const unsigned gg[8] = {g0.x, g0.y, g0.z, g0.w, g1.x, g1.y, g1.z, g1.w}, zz[8] = {z0.x, z0.y, z0.z, z0.w, z1.x, z1.y, z1.z, z1.w};
                unsigned w[8];
#pragma unroll
                for (int e = 0; e < 8; ++e) {
                    const float y0 = bf_lo(gg[e]) * sigmoidf_(acc[mi][ni][2 * e] + bq[ni][e >> 1][(e & 1) * 2]) * siluf_(bf_lo(zz[e]));
                    const float y1 = bf_hi(gg[e]) * sigmoidf_(acc[mi][ni][2 * e + 1] + bq[ni][e >> 1][(e & 1) * 2 + 1]) * siluf_(bf_hi(zz[e]));
                    ssq += y0 * y0 + y1 * y1;
                    w[e] = pk_bf16(y0, y1);
                }
                *(u32x4*)(Ys + (size_t)row * 512 + col) = (u32x4){w[0], w[1], w[2], w[3]}; *(u32x4*)(Ys + (size_t)row * 512 + col + 8) = (u32x4){w[4], w[5], w[6], w[7]};
            }
            ssq += __shfl_xor(ssq, 32);
            if (h == 0) ssqS[(size_t)row * 8 + (ncol0 >> 6)] = ssq;
        }
    }
};
__device__ __forceinline__ float rstd8(const float* p) {
    const f32x4 a = *(const f32x4*)p, b = *(const f32x4*)(p + 4);
    const float s = ((a[0] + a[1]) + (a[2] + a[3])) + ((b[0] + b[1]) + (b[2] + b[3]));
    return 1.0f / sqrtf(s * (1.0f / 512.0f) + NORM_EPS);
}
struct EpiOut {
    const float *x, *ssqA, *ssqS, *ln_g, *ln_b; float* out; unsigned long long* lnst; unsigned* cnt; unsigned target;
    __device__ __forceinline__ void mid(f32x16 (&acc)[2][2], int rowbase) const {
#pragma unroll
        for (int mi = 0; mi < 2; ++mi) {
            const int row = rowbase + mi * 32;
            const float f = rstd8(ssqA + (size_t)row * 8) / rstd8(ssqS + (size_t)row * 8);
#pragma unroll
            for (int ni = 0; ni < 2; ++ni)
#pragma unroll
                for (int r = 0; r < 16; ++r) acc[mi][ni][r] *= f;
        }
    }
    __device__ __forceinline__ void run(f32x16 (&acc)[2][2], int mrow0, int ncol0, int r32, int h) const {
#pragma unroll
        for (int mi = 0; mi < 2; ++mi) {
            const int row = mrow0 + mi * 32 + r32;
            const float rs = rstd8(ssqS + (size_t)row * 8);
            float sum = 0.f, sq = 0.f;
#pragma unroll
            for (int ni = 0; ni < 2; ++ni)
#pragma unroll
                for (int q = 0; q < 4; ++q) {
                    const int col = ncol0 + ni * 32 + q * 8 + h * 4;
                    const f32x4 xv = *(const f32x4*)(x + (size_t)row * 1024 + col);
#pragma unroll
                    for (int j = 0; j < 4; ++j) { const float hv = DN_ALPHA * xv[j] + acc[mi][ni][4 * q + j] * rs; acc[mi][ni][4 * q + j] = hv; sum += hv; sq += hv * hv; }
                }
            sum += __shfl_xor(sum, 32); sq += __shfl_xor(sq, 32);
            if (h == 0) __hip_atomic_store(lnst + (size_t)row * 16 + (ncol0 >> 6), ((unsigned long long)__float_as_uint(sq) << 32) | __float_as_uint(sum), __ATOMIC_RELAXED, __HIP_MEMORY_SCOPE_AGENT);
        }
        asm volatile("s_waitcnt vmcnt(0)" ::: "memory");
        if ((threadIdx.x & 63) == 0) __hip_atomic_fetch_add(cnt, 1u, __ATOMIC_RELAXED, __HIP_MEMORY_SCOPE_AGENT);
        { unsigned sp = 0; while (__hip_atomic_load(cnt, __ATOMIC_RELAXED, __HIP_MEMORY_SCOPE_AGENT) < target) { __builtin_amdgcn_s_sleep(2); if (++sp > (1u << 24)) break; } }
        asm volatile("" ::: "memory");
#pragma unroll
        for (int mi = 0; mi < 2; ++mi) {
            const int row = mrow0 + mi * 32 + r32;
            float sum = 0.f, sq = 0.f;
#pragma unroll
            for (int t = 0; t < 16; ++t) { const unsigned long long w = __hip_atomic_load(lnst + (size_t)row * 16 + t, __ATOMIC_RELAXED, __HIP_MEMORY_SCOPE_AGENT); sum += __uint_as_float((unsigned)w); sq += __uint_as_float((unsigned)(w >> 32)); }
            const float mean = sum * (1.0f / 1024.0f);
            const float var = fmaxf(sq * (1.0f / 1024.0f) - mean * mean, 0.f);
            const float rstd = 1.0f / sqrtf(var + NORM_EPS);
#pragma unroll
            for (int ni = 0; ni < 2; ++ni)
#pragma unroll
                for (int q = 0; q < 4; ++q) {
                    const int col = ncol0 + ni * 32 + q * 8 + h * 4;
                    const f32x4 gg = *(const f32x4*)(ln_g + col), bb = *(const f32x4*)(ln_b + col);
                    f32x4 o;
#pragma unroll
                    for (int j = 0; j < 4; ++j) o[j] = (acc[mi][ni][4 * q + j] - mean) * rstd * gg[j] + bb[j];
                    *(f32x4*)(out + (size_t)row * 1024 + col) = o;
                }
        }
    }
};


typedef float f32x4v __attribute__((ext_vector_type(4)));
constexpr int HTB = 128 * 64 * 2;
constexpr int LDS8_TAB = 8 * HTB;
__host__ __device__ __forceinline__ int lds_byte8(int r, int c) { const int st = (r >> 4) * 2 + (c >> 5), rr = r & 15, cc = c & 31, ob = rr * 64 + cc * 2; return st * 1024 + (ob ^ (((ob >> 9) & 1) << 5)); }
__host__ __device__ __forceinline__ void stage_rc8(int b, int& R, int& C) { const int st = b / 1024, sb = b % 1024, swz = sb ^ (((sb >> 9) & 1) << 5); R = (st >> 1) * 16 + swz / 64; C = (st & 1) * 32 + (swz % 64) / 2; }
#define MFMA16(a, b, c) __builtin_amdgcn_mfma_f32_16x16x32_bf16((a), (b), (c), 0, 0, 0)

__host__ __device__ __forceinline__ int perm32_8(int rho) { const int n = rho >> 4, i = rho & 15; return 8 * (i >> 2) + 4 * n + (i & 3); }
template <class Epi, class Sched, bool MID, bool AFTER_DRAIN, bool SP2>
__device__ __forceinline__ void gemm8_phase(LAS unsigned char* lds, const bf16_t* __restrict__ A0, const bf16_t* __restrict__ A1, int lda, int ksw,
                                            const bf16_t* __restrict__ Bt, int ldb, int nt, const Sched& S, const Epi& epi) {
    int tid = threadIdx.x; asm volatile("" : "+v"(tid));
    const int lane = tid & 63, wid = __builtin_amdgcn_readfirstlane(tid >> 6), wr = wid >> 2, wc = wid & 3, fr = lane & 15, fq = lane >> 4;
    int brow, bcol;
    if (!S.get(0, brow, bcol)) return;
    unsigned voffA[2], voffB[2];
#pragma unroll
    for (int i = 0; i < 2; ++i) { int R, C; stage_rc8(tid * 16 + i * 8192, R, C); const int Rb = Epi::PERM ? ((R & ~31) + perm32_8(R & 31)) : R; voffA[i] = (unsigned)(R * lda + C) * 2u; voffB[i] = (unsigned)(Rb * ldb + C) * 2u; }
    const unsigned ldsw = (unsigned)wid * 1024u;
    const int aoff = lds_byte8(wr * 64 + fr, fq * 8), boff = lds_byte8(wc * 32 + fr, fq * 8);
    const size_t hA = (size_t)128 * lda * 2, hB = (size_t)128 * ldb * 2;
    const char* cA0 = (const char*)A0 + (size_t)brow * lda * 2; const char* cA1 = (const char*)A1 + (size_t)brow * lda * 2;
    const char* cB = (const char*)Bt + (size_t)bcol * ldb * 2;
#define G8_SA(b, h) (((b) * 2 + (h)) * HTB)
#define G8_SB(b, h) ((4 + (b) * 2 + (h)) * HTB)
#define G8_AB(kt) ((kt) < ksw ? cA0 + (size_t)(kt) * 128 : cA1 + (size_t)((kt) - ksw) * 128)
#define G8_ST(off, gp, vo) do { const char* _g = (gp); _Pragma("unroll") for (int _i = 0; _i < 2; ++_i) \
        __builtin_amdgcn_global_load_lds((const unsigned*)(_g + vo[_i]), (LAS unsigned*)(lds + (off) + ldsw + _i * 8192), 16, 0, 0); } while (0)
#define G8_LDA(dst, b, h) do { _Pragma("unroll") for (int m = 0; m < 4; ++m) _Pragma("unroll") for (int k = 0; k < 2; ++k) dst[m][k] = *(const LAS bf16x8*)(lds + G8_SA(b, h) + aoff + m * 2048 + k * 1024); } while (0)
#define G8_LDB(dst, b, h) do { _Pragma("unroll") for (int n = 0; n < 2; ++n) _Pragma("unroll") for (int k = 0; k < 2; ++k) dst[n][k] = *(const LAS bf16x8*)(lds + G8_SB(b, h) + boff + n * 2048 + k * 1024); } while (0)
#define G8_MMA(ai, bj, At_, Bt_) do { __builtin_amdgcn_s_setprio(1); _Pragma("unroll") for (int m = 0; m < 4; ++m) _Pragma("unroll") for (int n = 0; n < 2; ++n) _Pragma("unroll") for (int k = 0; k < 2; ++k) \
        acc[ai][bj][m][n] = MFMA16(Bt_[n][k], At_[m][k], acc[ai][bj][m][n]); __builtin_amdgcn_s_setprio(0); } while (0)
#define G8_WV(n) asm volatile("s_waitcnt vmcnt(" #n ")" ::: "memory")
#define G8_WL(n) asm volatile("s_waitcnt lgkmcnt(" #n ")" ::: "memory")
#define G8_BAR __builtin_amdgcn_s_barrier()
#define G8_SCHED __builtin_amdgcn_sched_barrier(0)
    f32x4v acc[2][2][4][2];
#pragma unroll
    for (int a = 0; a < 2; ++a)
#pragma unroll
        for (int b = 0; b < 2; ++b)
#pragma unroll
            for (int m = 0; m < 4; ++m)
#pragma unroll
                for (int n = 0; n < 2; ++n) acc[a][b][m][n] = (f32x4v){0.f, 0.f, 0.f, 0.f};
    bf16x8 At[4][2], B0[2][2], B1[2][2];
    if constexpr (MID) epi.pre(brow, tid);
    if constexpr (SP2) {
        G8_ST(G8_SB(0, 0), cB, voffB); G8_ST(G8_SB(0, 1), cB + hB, voffB); G8_ST(G8_SA(0, 0), cA0, voffA); G8_ST(G8_SA(0, 1), cA0 + hA, voffA);
        if (wr == 1) G8_BAR;
        G8_WV(2); G8_BAR;
        G8_ST(G8_SB(1, 0), cB + 128, voffB); G8_ST(G8_SA(1, 0), G8_AB(1), voffA); G8_ST(G8_SB(1, 1), cB + 128 + hB, voffB);
        G8_WV(6); G8_BAR;
    } else {
    G8_ST(G8_SB(0, 0), cB, voffB); G8_ST(G8_SA(0, 0), cA0, voffA); G8_ST(G8_SB(0, 1), cB + hB, voffB); G8_ST(G8_SA(0, 1), cA0 + hA, voffA);
    if (wr == 1) G8_BAR;
    G8_WV(4); G8_BAR;
    G8_ST(G8_SB(1, 0), cB + 128, voffB); G8_ST(G8_SA(1, 0), G8_AB(1), voffA); G8_ST(G8_SB(1, 1), cB + 128 + hB, voffB);
    G8_WV(6); G8_BAR;
    }
    int ui = 0;
    for (;;) {
        int nbrow, nbcol; const bool has_next = S.get(ui + 1, nbrow, nbcol);
        const char* nA = has_next ? (const char*)A0 + (size_t)nbrow * lda * 2 : cA0; const char* nB = has_next ? (const char*)Bt + (size_t)nbcol * ldb * 2 : cB;
        for (int t = 0; t < nt; t += 2) {
            const bool last = (t == nt - 2);
            const char* a1 = G8_AB(t + 1);
            const char* a2 = last ? nA : G8_AB(t + 2); const char* b2 = last ? nB : cB + (size_t)(t + 2) * 128;
            const char* a3 = last ? nA + 128 : G8_AB(t + 3); const char* b3 = last ? nB + 128 : cB + (size_t)(t + 3) * 128;
            if constexpr (MID) { if (t == ksw) epi.mid(acc, wr * 64 + fr); }
            if constexpr (SP2) {
            G8_LDB(B0, 0, 0); G8_LDB(B1, 0, 1); G8_SCHED; G8_LDA(At, 0, 0); G8_ST(G8_SA(1, 1), a1 + hA, voffA);
            G8_WV(8); G8_WL(0); G8_BAR; G8_MMA(0, 0, At, B0); G8_MMA(0, 1, At, B1); G8_BAR; G8_SCHED;
            G8_LDA(At, 0, 1); G8_ST(G8_SB(0, 0), b2, voffB); G8_ST(G8_SB(0, 1), b2 + hB, voffB); G8_ST(G8_SA(0, 0), a2, voffA);
            G8_WV(8); G8_WL(0); G8_BAR; G8_MMA(1, 0, At, B0); G8_MMA(1, 1, At, B1); G8_BAR; G8_SCHED;
            G8_LDB(B0, 1, 0); G8_LDB(B1, 1, 1); G8_SCHED; G8_LDA(At, 1, 0); G8_ST(G8_SA(0, 1), a2 + hA, voffA);
            G8_WV(8); G8_WL(0); G8_BAR; G8_MMA(0, 0, At, B0); G8_MMA(0, 1, At, B1); G8_BAR; G8_SCHED;
            G8_LDA(At, 1, 1); G8_ST(G8_SB(1, 0), b3, voffB); G8_ST(G8_SB(1, 1), b3 + hB, voffB); G8_ST(G8_SA(1, 0), a3, voffA);
            G8_WV(8); G8_WL(0); G8_BAR; G8_MMA(1, 0, At, B0); G8_MMA(1, 1, At, B1); G8_BAR; G8_SCHED;
            } else {
            G8_LDB(B0, 0, 0); G8_SCHED; G8_LDA(At, 0, 0); G8_ST(G8_SA(1, 1), a1 + hA, voffA);
            G8_WL(8); G8_BAR; G8_WL(0); G8_MMA(0, 0, At, B0); G8_BAR; G8_SCHED;
            G8_LDB(B1, 0, 1); G8_ST(G8_SB(0, 0), b2, voffB);
            G8_BAR; G8_WL(0); G8_MMA(0, 1, At, B1); G8_BAR;
            G8_LDA(At, 0, 1); G8_ST(G8_SA(0, 0), a2, voffA);
            G8_BAR; G8_WL(0); G8_MMA(1, 0, At, B0); G8_BAR; G8_SCHED;
            G8_ST(G8_SB(0, 1), b2 + hB, voffB);
            G8_WV(6); G8_BAR; G8_MMA(1, 1, At, B1); G8_BAR;
            G8_LDB(B0, 1, 0); G8_SCHED; G8_LDA(At, 1, 0); G8_ST(G8_SA(0, 1), a2 + hA, voffA);
            G8_WL(8); G8_BAR; G8_WL(0); G8_MMA(0, 0, At, B0); G8_BAR; G8_SCHED;
            G8_LDB(B1, 1, 1); G8_ST(G8_SB(1, 0), b3, voffB);
            G8_BAR; G8_WL(0); G8_MMA(0, 1, At, B1); G8_BAR;
            G8_LDA(At, 1, 1); G8_ST(G8_SA(1, 0), a3, voffA);
            G8_BAR; G8_WL(0); G8_MMA(1, 0, At, B0); G8_BAR; G8_SCHED;
            G8_ST(G8_SB(1, 1), b3 + hB, voffB);
            G8_WV(6); G8_BAR; G8_MMA(1, 1, At, B1); G8_BAR;
            }
        }
        if constexpr (!AFTER_DRAIN) { if (wr == 0) G8_BAR; }
        if constexpr (!AFTER_DRAIN) epi.run(acc, brow + wr * 64 + fr, bcol + wc * 32 + fq * (Epi::PERM ? 8 : 4), wid, lane);
        if (!has_next) break;
#pragma unroll
        for (int a = 0; a < 2; ++a)
#pragma unroll
            for (int b = 0; b < 2; ++b)
#pragma unroll
                for (int m = 0; m < 4; ++m)
#pragma unroll
                    for (int n = 0; n < 2; ++n) acc[a][b][m][n] = (f32x4v){0.f, 0.f, 0.f, 0.f};
        brow = nbrow; bcol = nbcol; cA0 = nA; cA1 = (const char*)A1 + (size_t)nbrow * lda * 2; cB = nB; ++ui;
        if constexpr (!AFTER_DRAIN) { if (wr == 1) G8_BAR; }
    }
    G8_WV(0);
    if constexpr (AFTER_DRAIN) { if (wr == 0) G8_BAR; }
    G8_BAR;
    if constexpr (AFTER_DRAIN) epi.run(acc, brow + wr * 64 + fr, bcol + wc * 32 + fq * (Epi::PERM ? 8 : 4), wid, lane);
}
struct SchedProj { int bx, G, total;
    __device__ __forceinline__ bool get(int i, int& brow, int& bcol) const { const int t_ = bx + i * G; if (t_ >= total) return false; const int t = t_ % 576; const int grp = t / 36, w = t % 36;
        brow = (grp * 4 + (w & 3)) * 256; bcol = (w >> 2) * 256; return true; } };
struct SchedP1 { int bx, G, mode;
    __device__ __forceinline__ bool get(int i, int& brow, int& bcol) const {
        if (mode == 1) { if (i > 1) return false; const int t = bx + i * 256; const int grp = t >> 5, w = t & 31; brow = (grp * 4 + (w & 3)) * 256; bcol = (w >> 2) * 256; return true; }
        if (mode == 2) { if (i != 0 || bx >= 64) return false; brow = bx * 256; bcol = 8 * 256; return true; }
        const int t = bx + i * G; if (t >= 576) return false; const int grp = t / 72, w = t % 72; brow = (grp * 8 + (w & 7)) * 256; bcol = (w >> 3) * 256; return true; } };
struct SchedOut { int bx;
    __device__ __forceinline__ bool get(int i, int& brow, int& bcol) const { if (i != 0 || bx >= 256) return false; brow = (bx >> 2) * 256; bcol = (bx & 3) * 256; return true; } };

struct EpiProj8 {
    static constexpr bool PERM = true;
    bf16_t *Q, *Kk, *VT, *Za, *Ug, *Zs; const float* rope;
    __device__ __forceinline__ void run(const f32x4v (&acc)[2][2][4][2], int row0, int col0, int wid, int lane) const {
#pragma unroll
        for (int ai = 0; ai < 2; ++ai)
#pragma unroll
            for (int m = 0; m < 4; ++m) {
                const int row = row0 + ai * 128 + m * 16, t = row & 4095;
#pragma unroll
                for (int bj = 0; bj < 2; ++bj) {
                    const int col = col0 + bj * 128;
                    const int cb = col & ~63;
                    f32x4v v0 = acc[ai][bj][m][0], v1 = acc[ai][bj][m][1];
                    if (cb < 640) {
                        const int i0 = (col & 63) >> 1;
                        const f32x4 c0 = *(const f32x4*)(rope + ((size_t)t * 32 + i0) * 2), c1 = *(const f32x4*)(rope + ((size_t)t * 32 + i0 + 2) * 2);
                        float o0 = v0[0] * c0[0] - v0[1] * c0[1], o1 = v0[1] * c0[0] + v0[0] * c0[1], o2 = v0[2] * c0[2] - v0[3] * c0[3], o3 = v0[3] * c0[2] + v0[2] * c0[3];
                        float o4 = v1[0] * c1[0] - v1[1] * c1[1], o5 = v1[1] * c1[0] + v1[0] * c1[1], o6 = v1[2] * c1[2] - v1[3] * c1[3], o7 = v1[3] * c1[2] + v1[2] * c1[3];
                        if (cb < 512) { o0 *= QSCALE; o1 *= QSCALE; o2 *= QSCALE; o3 *= QSCALE; o4 *= QSCALE; o5 *= QSCALE; o6 *= QSCALE; o7 *= QSCALE; }
                        const u32x4 w = (u32x4){pk_bf16(o0, o1), pk_bf16(o2, o3), pk_bf16(o4, o5), pk_bf16(o6, o7)};
                        if (cb < 512) *(u32x4*)(Q + (size_t)row * 512 + col) = w; else *(u32x4*)(Kk + (size_t)row * 128 + (col - 512)) = w;
                    } else if (cb < 768) {
                        const int c = col - 640, b = row >> 12;
                        bf16_t* p = VT + ((size_t)(b * 128 + c)) * 4096 + t;
                        p[0] = to_bf16(v0[0]); p[4096] = to_bf16(v0[1]); p[8192] = to_bf16(v0[2]); p[12288] = to_bf16(v0[3]);
                        p[16384] = to_bf16(v1[0]); p[20480] = to_bf16(v1[1]); p[24576] = to_bf16(v1[2]); p[28672] = to_bf16(v1[3]);
                    } else {
                        const u32x4 w = (u32x4){pk_bf16(v0[0], v0[1]), pk_bf16(v0[2], v0[3]), pk_bf16(v1[0], v1[1]), pk_bf16(v1[2], v1[3])};
                        if (cb < 1280) *(u32x4*)(Za + (size_t)row * 512 + (col - 768)) = w;
                        else if (cb < 1792) { const int c = col - 1280; *(u32x4*)(Ug + ((size_t)(c >> 4) * 16384 + row) * 16 + (c & 15)) = w; }
                        else *(u32x4*)(Zs + (size_t)row * 512 + (col - 1792)) = w;
                    }
                }
            }
    }
};
struct EpiOut8 {
    static constexpr bool PERM = false;
    LAS unsigned char* lds; const float *x, *ssqA, *ssqS, *ln_g, *ln_b; float* out; unsigned long long* lnst; unsigned* cnt; unsigned target;
    __device__ __forceinline__ void pre(int brow, int tid) const {
        if (tid < 256) { const float ra = rstd8(ssqA + (size_t)(brow + tid) * 8), rs = rstd8(ssqS + (size_t)(brow + tid) * 8); *(LAS f32x2*)(lds + LDS8_TAB + tid * 8) = (f32x2){ra / rs, rs}; }
    }
    __device__ __forceinline__ void mid(f32x4v (&acc)[2][2][4][2], int lrow) const {
#pragma unroll
        for (int ai = 0; ai < 2; ++ai)
#pragma unroll
            for (int m = 0; m < 4; ++m) {
                const float f = (*(const LAS f32x2*)(lds + LDS8_TAB + (lrow + ai * 128 + m * 16) * 8)).x;
#pragma unroll
                for (int bj = 0; bj < 2; ++bj)
#pragma unroll
                    for (int n = 0; n < 2; ++n) acc[ai][bj][m][n] *= f;
            }
    }
    __device__ __forceinline__ void run(f32x4v (&acc)[2][2][4][2], int row0, int col0, int wid, int lane) const {
        const int fq = lane >> 4, wc = wid & 3, part = ((col0 - fq * 4) >> 8) * 4 + wc;
        f32x4 xv[2][4];
#pragma unroll
        for (int c = 0; c < 4; ++c) xv[0][c] = __builtin_nontemporal_load((const f32x4*)(x + (size_t)row0 * 1024 + col0 + (c >> 1) * 128 + (c & 1) * 16));
#pragma unroll
        for (int g = 0; g < 8; ++g) {
            const int ai = g >> 2, m = g & 3, row = row0 + ai * 128 + m * 16;
            if (g < 7) { const int row1 = row0 + ((g + 1) >> 2) * 128 + ((g + 1) & 3) * 16;
#pragma unroll
                for (int c = 0; c < 4; ++c) xv[(g + 1) & 1][c] = __builtin_nontemporal_load((const f32x4*)(x + (size_t)row1 * 1024 + col0 + (c >> 1) * 128 + (c & 1) * 16)); }
            const float rs = (*(const LAS f32x2*)(lds + LDS8_TAB + ((row & 255)) * 8)).y;
            float sum = 0.f, sq = 0.f;
#pragma unroll
            for (int c = 0; c < 4; ++c) {
                const int bj = c >> 1, n = c & 1;
                f32x4v hv;
#pragma unroll
                for (int j = 0; j < 4; ++j) { hv[j] = DN_ALPHA * xv[g & 1][c][j] + acc[ai][bj][m][n][j] * rs; sum += hv[j]; sq += hv[j] * hv[j]; }
                acc[ai][bj][m][n] = hv;
            }
            sum += __shfl_xor(sum, 16); sq += __shfl_xor(sq, 16); sum += __shfl_xor(sum, 32); sq += __shfl_xor(sq, 32);
            if (fq == 0) __hip_atomic_store(lnst + (size_t)row * 16 + part, ((unsigned long long)__float_as_uint(sq) << 32) | __float_as_uint(sum), __ATOMIC_RELAXED, __HIP_MEMORY_SCOPE_AGENT);
        }
        asm volatile("s_waitcnt vmcnt(0)" ::: "memory");
        if (lane == 0) __hip_atomic_fetch_add(cnt, 1u, __ATOMIC_RELAXED, __HIP_MEMORY_SCOPE_AGENT);
        f32x4 gg[4], bb[4];
#pragma unroll
        for (int c = 0; c < 4; ++c) { const int col = col0 + (c >> 1) * 128 + (c & 1) * 16; gg[c] = *(const f32x4*)(ln_g + col); bb[c] = *(const f32x4*)(ln_b + col); }
        { unsigned sp = 0; while (__hip_atomic_load(cnt, __ATOMIC_RELAXED, __HIP_MEMORY_SCOPE_AGENT) < target) { __builtin_amdgcn_s_sleep(2); if (++sp > (1u << 24)) break; } }
        asm volatile("" ::: "memory");
#pragma unroll
        for (int ai = 0; ai < 2; ++ai) {
            unsigned long long w[4][4];
#pragma unroll
            for (int m = 0; m < 4; ++m)
#pragma unroll
                for (int t = 0; t < 4; ++t) w[m][t] = __hip_atomic_load(lnst + (size_t)(row0 + ai * 128 + m * 16) * 16 + fq * 4 + t, __ATOMIC_RELAXED, __HIP_MEMORY_SCOPE_AGENT);
#pragma unroll
            for (int m = 0; m < 4; ++m) {
                const int row = row0 + ai * 128 + m * 16;
                float sum = 0.f, sq = 0.f;
#pragma unroll
                for (int t = 0; t < 4; ++t) { sum += __uint_as_float((unsigned)w[m][t]); sq += __uint_as_float((unsigned)(w[m][t] >> 32)); }
                sum += __shfl_xor(sum, 16); sq += __shfl_xor(sq, 16); sum += __shfl_xor(sum, 32); sq += __shfl_xor(sq, 32);
                const float mean = sum * (1.0f / 1024.0f);
                const float var = fmaxf(sq * (1.0f / 1024.0f) - mean * mean, 0.f);
                const float rstd = 1.0f / sqrtf(var + NORM_EPS);
#pragma unroll
                for (int c = 0; c < 4; ++c) {
                    const int bj = c >> 1, n = c & 1, col = col0 + bj * 128 + n * 16;
                    f32x4 o;
#pragma unroll
                    for (int j = 0; j < 4; ++j) o[j] = (acc[ai][bj][m][n][j] - mean) * rstd * gg[c][j] + bb[c][j];
                    __builtin_nontemporal_store(o, (f32x4*)(out + (size_t)row * 1024 + col));
                }
            }
        }
    }
};

struct SsmIn { const float *a_re, *a_im, *log_dt, *b_re, *b_im, *c_re, *c_im, *ssm_d; };
__device__ __forceinline__ void ssm_tables(LAS unsigned char* lds, const SsmIn P, float* lam_, bf16_t* Ws_, bf16_t* TW_, int g, int part) {
    int tid = threadIdx.x; asm volatile("" : "+v"(tid));
    LAS f32x2* pw = (LAS f32x2*)lds;
    LAS f32x2* Bb = (LAS f32x2*)(lds + 17408);
    LAS float* Kt = (LAS float*)(lds + 17408 + 16384);
    LAS f32x2* Cc = (LAS f32x2*)(lds + 17408 + 16384 + 32768);
    __syncthreads();
    {
        const int dir = (tid >> 6) & 1, p = tid & 63, dq = tid >> 7;
        const int gi = (dir * 32 + g) * 64 + p;
        const float dt = expf(P.log_dt[dir * 32 + g]);
        const float ar = P.a_re[gi], ai = P.a_im[gi];
        for (int d = dq; d <= 16; d += 4) {
            const float mg = expf((float)d * dt * ar); float sn, cn; sincosf((float)d * dt * ai, &sn, &cn);
            pw[(dir * 64 + p) * 17 + d] = (f32x2){mg * cn, mg * sn};
        }
        if (dq == 0) {
            const float mag = expf(dt * ar);
            const float lr = mag * cosf(dt * ai), li = mag * sinf(dt * ai);
            const float den = ar * ar + ai * ai;
            const float fr = ((lr - 1.0f) * ar + li * ai) / den, fi = (li * ar - (lr - 1.0f) * ai) / den;
            for (int ch = 0; ch < 16; ++ch) {
                const float br = P.b_re[(size_t)gi * 16 + ch], bi = P.b_im[(size_t)gi * 16 + ch];
                Bb[(dir * 64 + p) * 16 + ch] = (f32x2){fr * br - fi * bi, fr * bi + fi * br};
            }
        }
        if (dq == 1 && part == 0) {
            const double dar = (double)dt * (double)ar, dai = (double)dt * (double)ai;
            { const double mg = exp(dar * 16.0); double sn, cn; sincos(dai * 16.0, &sn, &cn);
              *(f32x2*)(lam_ + ((size_t)(g * 2 + dir) * 64 + p) * 2) = (f32x2){(float)(mg * cn), (float)(mg * sn)}; }
            { const double mg = exp(dar * 512.0); double sn, cn; sincos(dai * 512.0, &sn, &cn);
              *(f32x2*)(lam_ + 8192 + ((size_t)(g * 2 + dir) * 64 + p) * 2) = (f32x2){(float)(mg * cn), (float)(mg * sn)}; }
        }
        for (int i = tid; i < 2048; i += NT) { const int d2 = i >> 10, c = (i >> 6) & 15, pp = i & 63; const size_t ci = ((size_t)(d2 * 32 + g) * 16 + c) * 64 + pp; Cc[i] = (f32x2){P.c_re[ci], P.c_im[ci]}; }
    }
    __syncthreads();
    if (part == 0) for (int task = tid; task < 2048; task += NT) {
        const int dir = task >> 10, p = (task >> 4) & 63, j = task & 15;
        const int e = dir == 0 ? 15 - j : j;
        const f32x2 pwv = pw[(dir * 64 + p) * 17 + e];
        unsigned wr[8], wi[8];
#pragma unroll
        for (int c2 = 0; c2 < 8; ++c2) {
            const f32x2 b0 = Bb[(dir * 64 + p) * 16 + 2 * c2], b1 = Bb[(dir * 64 + p) * 16 + 2 * c2 + 1];
            wr[c2] = pk_bf16(pwv.x * b0.x - pwv.y * b0.y, pwv.x * b1.x - pwv.y * b1.y);
            wi[c2] = pk_bf16(pwv.x * b0.y + pwv.y * b0.x, pwv.x * b1.y + pwv.y * b1.x);
        }
        bf16_t* dst = Ws_ + ((size_t)g * 256 + dir * 128 + 2 * p) * 256 + j * 16;
        *(u32x4*)dst = (u32x4){wr[0], wr[1], wr[2], wr[3]}; *(u32x4*)(dst + 8) = (u32x4){wr[4], wr[5], wr[6], wr[7]};
        *(u32x4*)(dst + 256) = (u32x4){wi[0], wi[1], wi[2], wi[3]}; *(u32x4*)(dst + 256 + 8) = (u32x4){wi[4], wi[5], wi[6], wi[7]};
    }
    if (part == 1) for (int task = tid; task < 2048; task += NT) {
        const int dir = task >> 10, i = (task >> 6) & 15, p = task & 63;
        const int e = dir == 0 ? i + 1 : 16 - i;
        const f32x2 pwv = pw[(dir * 64 + p) * 17 + e];
#pragma unroll 4
        for (int c = 0; c < 16; ++c) {
            const f32x2 cc = Cc[(dir * 16 + c) * 64 + p];
            const float er = cc.x * pwv.x - cc.y * pwv.y, ei = cc.x * pwv.y + cc.y * pwv.x;
            *(unsigned*)(TW_ + ((size_t)g * 256 + i * 16 + c) * 512 + 256 + dir * 128 + 2 * p) = pk_bf16(er, -ei);
        }
    }
    if (part >= 2) {
        const int dir = tid >> 8, d = (tid >> 4) & 15, c = tid & 15;
        float a[16];
#pragma unroll
        for (int ch = 0; ch < 16; ++ch) a[ch] = 0.f;
        for (int p = 0; p < 64; ++p) {
            const f32x2 cc = Cc[(dir * 16 + c) * 64 + p];
            const f32x2 pwv = pw[(dir * 64 + p) * 17 + d];
            const float er = cc.x * pwv.x - cc.y * pwv.y, ei = cc.x * pwv.y + cc.y * pwv.x;
#pragma unroll
            for (int ch = 0; ch < 16; ++ch) { const f32x2 bb = Bb[(dir * 64 + p) * 16 + ch]; a[ch] += er * bb.x - ei * bb.y; }
        }
#pragma unroll
        for (int ch = 0; ch < 16; ++ch) Kt[((dir * 16 + d) * 16 + c) * 16 + ch] = a[ch];
    }
    __syncthreads();
    if (part >= 2) for (int task = (part - 2) * 4096 + tid; task < (part - 1) * 4096; task += NT) {
        const int n = task >> 5, kg = task & 31;
        const int i = n >> 4, c = n & 15, j = kg >> 1, ch0 = (kg & 1) * 8;
        float v[8];
#pragma unroll
        for (int e = 0; e < 8; ++e) {
            float sacc = 0.f;
            if (j <= i) sacc += Kt[((0 * 16 + (i - j)) * 16 + c) * 16 + ch0 + e];
            if (j >= i) sacc += Kt[((1 * 16 + (j - i)) * 16 + c) * 16 + ch0 + e];
            if (i == j && c == ch0 + e) sacc += P.ssm_d[g * 16 + c];
            v[e] = sacc;
        }
        *(u32x4*)(TW_ + ((size_t)g * 256 + n) * 512 + kg * 8) = (u32x4){pk_bf16(v[0], v[1]), pk_bf16(v[2], v[3]), pk_bf16(v[4], v[5]), pk_bf16(v[6], v[7])};
    }
    __syncthreads();
}

__device__ __forceinline__ void phase_prologue(LAS unsigned char* lds, const Args& args) {
    int tid = threadIdx.x; asm volatile("" : "+v"(tid));
    unsigned char* ws = args.ws;
    const size_t gtid = (size_t)blockIdx.x * NT + tid, gsz = (size_t)gridDim.x * NT;
    {
        const float* x = args.in[0]; bf16_t* Xb = (bf16_t*)(ws + WS_XB);
        for (size_t i = gtid; i < (size_t)MTOK * DM / 8; i += gsz) {
            const f32x4 a = __builtin_nontemporal_load((const f32x4*)(x + i * 8)), b = __builtin_nontemporal_load((const f32x4*)(x + i * 8 + 4));
            *(u32x4*)(Xb + i * 8) = (u32x4){pk_bf16(a[0], a[1]), pk_bf16(a[2], a[3]), pk_bf16(b[0], b[1]), pk_bf16(b[2], b[3])};
        }
    }
    {
        const float* w_in = args.in[1]; bf16_t* WinT = (bf16_t*)(ws + WS_WINT);
        for (size_t i = gtid; i < (size_t)NPROJ * 128; i += gsz) {
            const int n = (int)(i % NPROJ), kg = (int)(i / NPROJ);
            int src = n;
            if (n < 640) { const int c = n & 63; src = (n & ~63) + ((c & 1) ? 32 + (c >> 1) : (c >> 1)); }
            float v[8];
#pragma unroll
            for (int j = 0; j < 8; ++j) v[j] = w_in[(size_t)(kg * 8 + j) * NPROJ + src];
            *(u32x4*)(WinT + (size_t)n * 1024 + kg * 8) = (u32x4){pk_bf16(v[0], v[1]), pk_bf16(v[2], v[3]), pk_bf16(v[4], v[5]), pk_bf16(v[6], v[7])};
        }
    }
    {
        float* rope = (float*)(ws + WS_ROPE);
        for (size_t i = gtid; i < (size_t)4096 * 32; i += gsz) {
            const int t = (int)(i >> 5), k = (int)(i & 31);
            const float inv_freq = powf(10000.0f, -(float)k / 32.0f);
            const float ang = (float)t * inv_freq;
            double sn, cn; sincos((double)ang, &sn, &cn);
            *(f32x2*)(rope + i * 2) = (f32x2){(float)cn, (float)sn};
        }
    }
}

__device__ __forceinline__ void phase_prologue_b(LAS unsigned char* lds, const Args& args, int sb, int nsb) {
    int tid = threadIdx.x; asm volatile("" : "+v"(tid));
    unsigned char* ws = args.ws;
    const size_t gtid = (size_t)sb * NT + tid, gsz = (size_t)nsb * NT;
    {
        const SsmIn SI{args.in[3], args.in[4], args.in[5], args.in[6], args.in[7], args.in[8], args.in[9], args.in[10]};
        for (int u = sb; u < 128; u += nsb) ssm_tables(lds, SI, (float*)(ws + WS_LAM), (bf16_t*)(ws + WS_WS), (bf16_t*)(ws + WS_TW), u >> 2, u & 3);
    }
    {
        const float* w_glu = args.in[11]; bf16_t* WgluT = (bf16_t*)(ws + WS_WGLUT);
        for (size_t i = gtid; i < (size_t)512 * 64; i += gsz) {
            const int n = (int)(i & 511), kg = (int)(i >> 9);
            float v[8];
#pragma unroll
            for (int j = 0; j < 8; ++j) v[j] = w_glu[(size_t)(kg * 8 + j) * 512 + n];
            *(u32x4*)(WgluT + (size_t)n * 512 + kg * 8) = (u32x4){pk_bf16(v[0], v[1]), pk_bf16(v[2], v[3]), pk_bf16(v[4], v[5]), pk_bf16(v[6], v[7])};
        }
    }
    {
        const float* w_out = args.in[15]; const float* g_attn = args.in[13]; const float* g_ssm = args.in[14]; bf16_t* WoutT = (bf16_t*)(ws + WS_WOUTT);
        for (size_t i = gtid; i < (size_t)1024 * 128; i += gsz) {
            const int n = (int)(i & 1023), kg = (int)(i >> 10);
            float v[8];
#pragma unroll
            for (int j = 0; j < 8; ++j) { const int k = kg * 8 + j; const float gn = k < 512 ? g_attn[k] : g_ssm[k - 512]; v[j] = w_out[(size_t)k * 1024 + n] * gn; }
            *(u32x4*)(WoutT + (size_t)n * 1024 + kg * 8) = (u32x4){pk_bf16(v[0], v[1]), pk_bf16(v[2], v[3]), pk_bf16(v[4], v[5]), pk_bf16(v[6], v[7])};
        }
    }
}

constexpr int VROWB = 136;
struct AttnP { const bf16_t *Q, *Kk, *VT, *Za; const float* sink; bf16_t* Ya; float* ssqA; };
__device__ __forceinline__ void attn_item(LAS unsigned char* lds, const AttnP P, int it) {
    int tid = threadIdx.x; asm volatile("" : "+v"(tid));
    const int lane = tid & 63, hd = __builtin_amdgcn_readfirstlane(tid >> 6), kvh = hd >> 2, r32 = lane & 31, h = lane >> 5;
    const int b = it >> 6, q0 = (it & 63) * 64;
    const size_t row0 = (size_t)b * 4096 + q0;
    bf16x8 qf[2][4];
#pragma unroll
    for (int nq = 0; nq < 2; ++nq)
#pragma unroll
        for (int s = 0; s < 4; ++s) qf[nq][s] = *(const bf16x8*)(P.Q + (row0 + nq * 32 + r32) * 512 + hd * 64 + s * 16 + h * 8);
    const float sink2 = P.sink[hd] * LOG2E;
    float mrun[2] = {sink2, sink2}, lrun[2] = {1.f, 1.f};
    f32x16 O[2][2];
#pragma unroll
    for (int i = 0; i < 2; ++i)
#pragma unroll
        for (int j = 0; j < 2; ++j)
#pragma unroll
            for (int r = 0; r < 16; ++r) O[i][j][r] = 0.f;
    LAS unsigned char* Ks = lds;
    LAS unsigned char* Vs = lds + 2 * 64 * ROWB;
    const int kb_lo = (q0 >= 128) ? -2 : -(q0 >> 6), kb_hi = (q0 + 128 <= 4032) ? 2 : ((4032 - q0) >> 6);
    u32x4 pk[2], pv[2];
#define AT_LOAD(kb_) do { const int _ks = q0 + (kb_) * 64; \
        _Pragma("unroll") for (int i = 0; i < 2; ++i) { const int c = tid + i * NT; \
            pk[i] = *(const u32x4*)(P.Kk + ((size_t)b * 4096 + _ks + (c >> 4)) * 128 + (c & 15) * 8); \
            pv[i] = *(const u32x4*)(P.VT + ((size_t)(b * 128 + (c >> 3))) * 4096 + _ks + (c & 7) * 8); } } while (0)
    AT_LOAD(kb_lo);
    for (int kb = kb_lo; kb <= kb_hi; ++kb) {
        __syncthreads();
#pragma unroll
        for (int i = 0; i < 2; ++i) {
            const int c = tid + i * NT, key = c >> 4, part = c & 15;
            *(LAS u32x4*)(Ks + ((part >> 3) * 64 + key) * ROWB + (part & 7) * 16) = pk[i];
            const int rowv = c >> 3, c8 = c & 7;
            *(LAS u32x2*)(Vs + rowv * VROWB + c8 * 16) = (u32x2){pv[i].x, pv[i].y};
            *(LAS u32x2*)(Vs + rowv * VROWB + c8 * 16 + 8) = (u32x2){pv[i].z, pv[i].w};
        }
        __syncthreads();
        if (kb < kb_hi) AT_LOAD(kb + 1);
#pragma unroll
        for (int nq = 0; nq < 2; ++nq) {
            f32x16 S[2];
#pragma unroll
            for (int r = 0; r < 16; ++r) { S[0][r] = 0.f; S[1][r] = 0.f; }
#pragma unroll
            for (int s = 0; s < 4; ++s) {
                const bf16x8 k0 = *(const LAS bf16x8*)(Ks + (kvh * 64 + r32) * ROWB + s * 32 + h * 16);
                const bf16x8 k1 = *(const LAS bf16x8*)(Ks + (kvh * 64 + 32 + r32) * ROWB + s * 32 + h * 16);
                S[0] = MFMA32(k0, qf[nq][s], S[0]);
                S[1] = MFMA32(k1, qf[nq][s], S[1]);
            }
            if (kb == -2 || kb == 2) {
                int base = nq * 32 + r32 - 4 * h;
                asm volatile("" : "+v"(base));
#pragma unroll
                for (int kg = 0; kg < 2; ++kg)
#pragma unroll
                    for (int r = 0; r < 16; ++r) {
                        const int kk = kg * 32 + (r & 3) + 8 * (r >> 2);
                        const bool ok = (kb == -2) ? (kk >= base) : (kk <= base);
                        S[kg][r] = ok ? S[kg][r] : -1e30f;
                    }
            }
            float mx = S[0][0];
#pragma unroll
            for (int r = 1; r < 16; ++r) mx = fmaxf(mx, S[0][r]);
#pragma unroll
            for (int r = 0; r < 16; ++r) mx = fmaxf(mx, S[1][r]);
            mx = fmaxf(mx, __shfl_xor(mx, 32));
            const float mnew = fmaxf(mrun[nq], mx);
            const float alpha = fast_exp2(mrun[nq] - mnew);
            float rs = 0.f;
#pragma unroll
            for (int kg = 0; kg < 2; ++kg)
#pragma unroll
                for (int r = 0; r < 16; ++r) { const float p = fast_exp2(S[kg][r] - mnew); S[kg][r] = p; rs += p; }
            rs += __shfl_xor(rs, 32);
            lrun[nq] = lrun[nq] * alpha + rs; mrun[nq] = mnew;
#pragma unroll
            for (int dg = 0; dg < 2; ++dg)
#pragma unroll
                for (int r = 0; r < 16; ++r) O[dg][nq][r] *= alpha;
#pragma unroll
            for (int kg = 0; kg < 2; ++kg)
#pragma unroll
                for (int s2 = 0; s2 < 2; ++s2) {
                    const u32x4 w = (u32x4){pk_bf16(S[kg][8 * s2], S[kg][8 * s2 + 1]), pk_bf16(S[kg][8 * s2 + 2], S[kg][8 * s2 + 3]),
                                            pk_bf16(S[kg][8 * s2 + 4], S[kg][8 * s2 + 5]), pk_bf16(S[kg][8 * s2 + 6], S[kg][8 * s2 + 7])};
                    const bf16x8 pf = __builtin_bit_cast(bf16x8, w);
#pragma unroll
                    for (int dg = 0; dg < 2; ++dg) {
                        const LAS unsigned char* vb = Vs + (kvh * 64 + dg * 32 + r32) * VROWB + (kg * 32 + s2 * 16 + 4 * h) * 2;
                        const u32x2 lo = *(const LAS u32x2*)vb, hi = *(const LAS u32x2*)(vb + 16);
                        const bf16x8 vf = __builtin_bit_cast(bf16x8, ((u32x4){lo.x, lo.y, hi.x, hi.y}));
                        O[dg][nq] = MFMA32(vf, pf, O[dg][nq]);
                    }
                }
        }
    }
#pragma unroll
    for (int nq = 0; nq < 2; ++nq) {
        const size_t row = row0 + nq * 32 + r32;
        const float inv = 1.0f / lrun[nq];
        float ssq = 0.f;
#pragma unroll
        for (int dg = 0; dg < 2; ++dg)
#pragma unroll
            for (int q = 0; q < 4; ++q) {
                const int d = hd * 64 + dg * 32 + q * 8 + h * 4;
                const u32x2 zw = *(const u32x2*)(P.Za + row * 512 + d);
                const float y0 = O[dg][nq][4 * q] * inv * siluf_(bf_lo(zw.x)), y1 = O[dg][nq][4 * q + 1] * inv * siluf_(bf_hi(zw.x));
                const float y2 = O[dg][nq][4 * q + 2] * inv * siluf_(bf_lo(zw.y)), y3 = O[dg][nq][4 * q + 3] * inv * siluf_(bf_hi(zw.y));
                ssq += (y0 * y0 + y1 * y1) + (y2 * y2 + y3 * y3);
                u32x2 w; w.x = pk_bf16(y0, y1); w.y = pk_bf16(y2, y3);
                *(u32x2*)(P.Ya + row * 512 + d) = w;
            }
        ssq += __shfl_xor(ssq, 32);
        if (h == 0) P.ssqA[row * 8 + hd] = ssq;
    }
}

#ifndef G8_SP2
#define G8_SP2 true
#endif
constexpr int NPHASE = 6;
#ifndef REP0
#define REP0 1
#endif
#ifndef REP1
#define REP1 1
#endif
#ifndef REP2
#define REP2 1
#endif
#ifndef REP3
#define REP3 1
#endif
#ifndef REP4
#define REP4 1
#endif
#ifndef REP5
#define REP5 1
#endif
#ifndef REP6
#define REP6 1
#endif
__global__ void __launch_bounds__(NT) fwd_kernel(Args args) {
    extern __shared__ __attribute__((aligned(16))) unsigned char lds_raw[];
    LAS unsigned char* lds = (LAS unsigned char*)lds_raw;
    const int tid = threadIdx.x;
    unsigned char* ws = args.ws;
    volatile LAS unsigned* st = (volatile LAS unsigned*)(lds + LDS_MAIN2);
    if (tid < 16) st[tid] = 0u;
    __syncthreads();
    const int lo = args.ph_lo, hi = args.ph_hi;
    XcdBarrier bar; bar.bar = (unsigned*)(ws + WS_BAR); bar.x = 0; bar.st = st;
    if (hi - lo > 1) bar = xcd_barrier_post((unsigned*)(ws + WS_BAR), st);
    if (args.never) cg::this_grid().sync();
#ifndef ONLY
#define ONLY -1
#endif
#ifndef PHMASK
#define PHMASK 255
#endif
#define IN(k) (((PHMASK >> (k)) & 1) && (ONLY < 0 || ONLY == (k)) && lo <= (k) && (k) < hi)
#define SEAM(k) do { if (IN(k) && IN((k) + 1)) xcd_barrier(bar); } while (0)
    const int G = gridDim.x, bx = (gridDim.x % 8 == 0) ? (int)((blockIdx.x % 8) * (gridDim.x / 8) + blockIdx.x / 8) : (int)blockIdx.x;

    if (IN(0)) for (int rep = 0; rep < REP0; ++rep) phase_prologue(lds, args);
    SEAM(0);
    const bool fast = false;
    unsigned* evt = (unsigned*)(ws + WS_BAR) + 64;
    if (IN(1)) {
        const bf16_t* Xb = (const bf16_t*)(ws + WS_XB); const bf16_t* WinT = (const bf16_t*)(ws + WS_WINT);
        EpiProj8 E8{(bf16_t*)(ws + WS_Q), (bf16_t*)(ws + WS_K), (bf16_t*)(ws + WS_VT), (bf16_t*)(ws + WS_ZA), (bf16_t*)(ws + WS_UG), (bf16_t*)(ws + WS_ZS), (const float*)(ws + WS_ROPE)};
#pragma clang loop unroll(disable)
        for (int stage = 0; stage < (fast ? 2 : 1); ++stage) {
            const SchedP1 SP{bx, G, fast ? stage + 1 : 0};
            gemm8_phase<EpiProj8, SchedP1, false, false, G8_SP2>(lds, Xb, Xb, 1024, 1 << 20, WinT, 1024, 16, SP, E8);
            if (stage == 0) {
                if (fast) { if (bx >= 64) phase_prologue_b(lds, args, bx - 64, 192); }
                else { int ntile = 0; for (int t_ = bx; t_ < 576; t_ += G) ++ntile; const int nr = (576 + G - 1) / G;
                    if (ntile < nr || G >= 576) { int nshort = nr * G - 576, first = G - nshort; if (nshort <= 0 || nshort > G) { nshort = G; first = 0; } if (bx >= first) phase_prologue_b(lds, args, bx - first, nshort); } }
                if (fast) {
                    asm volatile("s_waitcnt vmcnt(0)" ::: "memory");
                    __syncthreads();
                    if (tid == 0) { __builtin_amdgcn_fence(__ATOMIC_RELEASE, "agent"); asm volatile("s_waitcnt vmcnt(0)" ::: "memory"); (void)xb_add(evt, 1u); }
                }
            }
        }
    }
    if (fast) {
        if (tid == 0) { XB_SPIN(xb_ld(evt) < 256u, (unsigned*)(ws + WS_BAR)); __builtin_amdgcn_fence(__ATOMIC_ACQUIRE, "agent"); asm volatile("s_waitcnt vmcnt(0)" ::: "memory"); }
        __syncthreads();
    } else SEAM(1);
    if (IN(2)) {
        const AttnP AP{(const bf16_t*)(ws + WS_Q), (const bf16_t*)(ws + WS_K), (const bf16_t*)(ws + WS_VT), (const bf16_t*)(ws + WS_ZA), args.in[2], (bf16_t*)(ws + WS_YA), (float*)(ws + WS_SSQA)};
        int a0 = bx, as_ = G, an = (256 - bx + G - 1) / G, t0 = bx, ts = G, tn = (256 - bx + G - 1) / G;
        if (bx >= 256) { an = 0; tn = 0; }
        if (fast) { const int wi = bx - 64; a0 = wi; as_ = 192; an = wi < 0 ? 0 : (wi < 64 ? 2 : 1); t0 = 2 * (wi - 64); ts = 1; tn = wi >= 64 ? 2 : 0; }
#pragma clang loop unroll(disable)
        for (int k = 0; k < an; ++k) attn_item(lds, AP, a0 + k * as_);
        __syncthreads();
#pragma clang loop unroll(disable)
        for (int k = 0; k < tn; ++k) { const int t = t0 + k * ts; const int g = t >> 3, mt = (t >> 1) & 3, nt_ = t & 1;
            EpiSScan E{lds, (const float*)(ws + WS_LAM), (bf16_t*)(ws + WS_XIN), g, mt, nt_};
            const bf16_t* A = (const bf16_t*)(ws + WS_UG) + (size_t)g * 16384 * 16;
            gemm_tile<EpiSScan, false>(lds, A, 256, A, 256, 1 << 30, (const bf16_t*)(ws + WS_WS) + (size_t)g * 256 * 256, 256, 256, mt * BM, nt_ * BN, E); }
    }
    SEAM(2);
    if (IN(3)) {
        for (int t_ = bx; t_ < 256 * REP4; t_ += G) { const int t = t_ & 255; const int g = t >> 3, mt = (t >> 1) & 3, nt_ = t & 1;
            EpiY E{(bf16_t*)(ws + WS_G), g};
            gemm_tile<EpiY, false>(lds, (const bf16_t*)(ws + WS_UG) + (size_t)g * 16384 * 16, 256, (const bf16_t*)(ws + WS_XIN) + (size_t)g * 1024 * 256, 256, 256, (const bf16_t*)(ws + WS_TW) + (size_t)g * 256 * 512, 512, 512, mt * BM, nt_ * BN, E); }
    }
    SEAM(3);
    if (IN(4)) {
        EpiGlu E{(const bf16_t*)(ws + WS_G), (const bf16_t*)(ws + WS_ZS), args.in[12], (bf16_t*)(ws + WS_YS), (float*)(ws + WS_SSQS)};
        const bf16_t* Gp = (const bf16_t*)(ws + WS_G); const bf16_t* WgluT = (const bf16_t*)(ws + WS_WGLUT);
        for (int t_ = bx; t_ < 64 * 4 * REP5; t_ += G) { const int t = t_ & 255; const int mt = t >> 2, nt_ = t & 3;
            gemm_tile<EpiGlu, false>(lds, Gp, 512, Gp, 512, 1 << 30, WgluT, 512, 512, mt * BM, nt_ * BN, E); }
    }
    SEAM(4);
    if (IN(5)) {
        const bf16_t* Ya = (const bf16_t*)(ws + WS_YA); const bf16_t* Ys = (const bf16_t*)(ws + WS_YS); const bf16_t* WoutT = (const bf16_t*)(ws + WS_WOUTT);
        if (bx < 256) { const int mt = bx >> 2;
            EpiOut8 E{lds, args.in[0], (const float*)(ws + WS_SSQA), (const float*)(ws + WS_SSQS), args.in[16], args.in[17], args.out, (unsigned long long*)(ws + WS_LNST),
                      (unsigned*)(ws + WS_CNT) + mt * 64, 32u};
            const SchedOut SO{bx};
            gemm8_phase<EpiOut8, SchedOut, true, true, G8_SP2>(lds, Ya, Ys, 512, 8, WoutT, 1024, 16, SO, E); }
    }
#undef IN
#undef SEAM
}

extern "C" void kernel_launch(void* const* d_in, const int* in_sizes, int n_in, void* d_out, int out_size, void* d_ws, size_t ws_size, hipStream_t stream) {
    static int grid = 0;
    if (grid == 0) {
        if (n_in != 18 || ws_size < WS_END) { fprintf(stderr, "kernel_launch: unexpected inputs (n_in %d, ws %zu, need %zu)\n", n_in, ws_size, (size_t)WS_END); grid = -1; return; }
        int dev = 0, cus = 0, per_cu = 0;
        hipGetDevice(&dev);
        hipDeviceGetAttribute(&cus, hipDeviceAttributeMultiprocessorCount, dev);
        if (hipFuncSetAttribute((const void*)fwd_kernel, hipFuncAttributeMaxDynamicSharedMemorySize, LDS_BYTES) != hipSuccess) { fprintf(stderr, "kernel_launch: hipFuncSetAttribute failed\n"); grid = -1; return; }
        if (hipOccupancyMaxActiveBlocksPerMultiprocessor(&per_cu, (const void*)fwd_kernel, NT, LDS_BYTES) != hipSuccess || per_cu < 1) { fprintf(stderr, "kernel_launch: occupancy query says %d\n", per_cu); per_cu = 1; }
        (void)hipGetLastError();
        grid = cus;
    }
    if (grid < 0) return;
    (void)hipMemsetAsync((char*)d_ws + WS_BAR, 0, 32768, stream);
    Args a{};
    for (int i = 0; i < 18; ++i) a.in[i] = (const float*)d_in[i];
    a.out = (float*)d_out; a.ws = (unsigned char*)d_ws; a.never = 0; a.pad = 0;
#if N_LAUNCH_MODE == 1
    for (int ph = 0; ph < NPHASE; ++ph) {
        a.ph_lo = ph; a.ph_hi = ph + 1;
        hipLaunchKernelGGL(fwd_kernel, dim3(grid), dim3(NT), LDS_BYTES, stream, a);
    }
#else
    a.ph_lo = 0; a.ph_hi = NPHASE;
    void* kargs[] = {&a};
    hipError_t e = hipLaunchCooperativeKernel((const void*)fwd_kernel, dim3(grid), dim3(NT), kargs, LDS_BYTES, stream);
    if (e != hipSuccess) fprintf(stderr, "kernel_launch: cooperative launch failed: %s (grid %d)\n", hipGetErrorString(e), grid);
#endif
}
```
